# Optimizing an MI355X kernel written in HIP

```python
import jax, jax.numpy as jnp
from jax import lax
import numpy as np

D_MODEL = 1024
BATCH = 2
SEQ = 8192
DEPTH = 1

GRID_W = 64
CTX_LEN = 256
D_MIX = D_MODEL
RET_HEADS = 4
RET_WIDTH = D_MIX // 2
RET_DK = RET_WIDTH // RET_HEADS
RET_DV = RET_WIDTH // RET_HEADS
GLA_HEADS = 4
GLA_WIDTH = D_MIX - RET_WIDTH
GLA_DV = GLA_WIDTH // GLA_HEADS
GLA_DK = GLA_DV // 2
GLA_RANK = 16
GLA_GATE_NORM = 16.0
CHUNK = 64
ROPE_BASE = 10000.0
N_KEYS = 128
N_EXPERTS = N_KEYS * N_KEYS
PEER_HEADS = 8
PEER_TOPK = 16
PEER_DQ = 256
PEER_BLOCK = 128
N_MOD = 6
EPS = 1e-6
IN_SIZES = (RET_WIDTH, RET_WIDTH, RET_WIDTH, RET_WIDTH,
            GLA_HEADS * GLA_DK, GLA_HEADS * GLA_DK, GLA_WIDTH, GLA_WIDTH,
            GLA_RANK, GLA_RANK)
IN_COLS = sum(IN_SIZES)

kernel_name = "hymba_retention_gla_peer_dit"

F32 = jnp.float32


def rmsnorm(x, w):
    xf = x.astype(F32)
    y = xf * lax.rsqrt(jnp.mean(xf * xf, axis=-1, keepdims=True) + EPS)
    return (y * w.astype(F32)).astype(x.dtype)


def head_rmsnorm(o):
    o = o * lax.rsqrt(jnp.mean(o * o, axis=-1, keepdims=True) + EPS)
    B, H, L, d = o.shape
    return o.transpose(0, 2, 1, 3).reshape(B, L, H * d)


def modulate(h, shift, scale):
    return h * (1 + scale) + shift


def to_heads(t, n_heads):
    B, L, W = t.shape
    return t.reshape(B, L, n_heads, W // n_heads).transpose(0, 2, 1, 3)


def flip_seq(t):
    return jnp.flip(t, axis=2)


def axial_rope(rows, cols):
    r, c = jnp.meshgrid(jnp.arange(rows, dtype=F32), jnp.arange(cols, dtype=F32), indexing="ij")
    n_freq = RET_DK // 4
    inv = ROPE_BASE ** (-jnp.arange(n_freq, dtype=F32) / n_freq)
    ang = jnp.concatenate([r.reshape(-1, 1) * inv, c.reshape(-1, 1) * inv], axis=-1)
    return jnp.cos(ang), jnp.sin(ang)


def apply_rope(t, cos, sin):
    t1, t2 = jnp.split(t, 2, axis=-1)
    return jnp.concatenate([t1 * cos - t2 * sin, t2 * cos + t1 * sin], axis=-1)


def to_chunks(t):
    B, H, L, d = t.shape
    return t.reshape(B, H, L // CHUNK, CHUNK, d).transpose(2, 0, 1, 3, 4)


def from_chunks(t):
    n, B, H, C, d = t.shape
    return t.transpose(1, 2, 0, 3, 4).reshape(B, H, n * C, d)


def retention_scan(q, k, v, log_gamma, s0):
    idx = jnp.arange(CHUNK, dtype=F32)
    rel = idx[:, None] - idx[None, :]
    lg = log_gamma[:, None, None]
    decay_mask = jnp.where(rel >= 0, jnp.exp(lg * jnp.maximum(rel, 0.0)), 0.0)
    q_dec = jnp.exp(log_gamma[:, None] * (idx + 1.0))[None, :, :, None]
    k_dec = jnp.exp(log_gamma[:, None] * (CHUNK - 1.0 - idx))[None, :, :, None]
    chunk_dec = jnp.exp(log_gamma * CHUNK)[None, :, None, None]

    def step(s, inp):
        qc, kc, vc = inp
        scores = jnp.einsum("bhid,bhjd->bhij", qc, kc) * decay_mask
        out = (jnp.einsum("bhij,bhjv->bhiv", scores, vc)
               + jnp.einsum("bhid,bhdv->bhiv", qc * q_dec, s))
        s = chunk_dec * s + jnp.einsum("bhjd,bhjv->bhdv", kc * k_dec, vc)
        return s, out

    s, out = lax.scan(step, s0, (to_chunks(q), to_chunks(k), to_chunks(v)))
    return from_chunks(out), s


def gla_scan(q, k, v, log_a, s0):
    causal = (jnp.arange(CHUNK)[:, None] >= jnp.arange(CHUNK)[None, :])

    def step(s, inp):
        qc, kc, vc, ac = inp
        G = jnp.cumsum(ac, axis=2)
        G_last = G[:, :, -1:, :]
        q_t = qc * jnp.exp(G)
        k_t = kc * jnp.exp(-G)
        scores = jnp.where(causal, jnp.einsum("bhid,bhjd->bhij", q_t, k_t), 0.0)
        out = (jnp.einsum("bhij,bhjv->bhiv", scores, vc)
               + jnp.einsum("bhid,bhdv->bhiv", q_t, s))
        s = (jnp.exp(G_last[:, :, 0, :])[..., None] * s
             + jnp.einsum("bhjd,bhjv->bhdv", kc * jnp.exp(G_last - G), vc))
        return s, out

    s, out = lax.scan(step, s0, (to_chunks(q), to_chunks(k), to_chunks(v), to_chunks(log_a)))
    return from_chunks(out), s


def retention_final_state(k, v, log_gamma):
    L = k.shape[2]
    w = jnp.exp(log_gamma[:, None] * (L - 1.0 - jnp.arange(L, dtype=F32)))
    return jnp.einsum("bhld,bhle->bhde", k * w[None, :, :, None], v)


def gla_final_state(k, v, log_a):
    G = jnp.cumsum(log_a, axis=2)
    return jnp.einsum("bhld,bhle->bhde", k * jnp.exp(G[:, :, -1:, :] - G), v)


def project(h, w_in, gk_up_f, gk_bias_f, gk_up_b, gk_bias_b, rope):
    p = (h @ w_in).astype(F32)
    splits = [int(s) for s in np.cumsum(IN_SIZES)[:-1]]
    rq, rk, rv, rg, gq, gk, gv, gg, lr_f, lr_b = jnp.split(p, splits, axis=-1)
    rq = to_heads(rq, RET_HEADS)
    rk = to_heads(rk, RET_HEADS) * (RET_DK ** -0.5)
    rv = to_heads(rv, RET_HEADS)
    if rope is not None:
        rq = apply_rope(rq, *rope)
        rk = apply_rope(rk, *rope)
    gq = to_heads(gq, GLA_HEADS) * (GLA_DK ** -0.5)
    gk = to_heads(gk, GLA_HEADS)
    gv = to_heads(gv, GLA_HEADS)
    la_f = to_heads(jax.nn.log_sigmoid(lr_f @ gk_up_f.astype(F32) + gk_bias_f.astype(F32)) / GLA_GATE_NORM, GLA_HEADS)
    la_b = to_heads(jax.nn.log_sigmoid(lr_b @ gk_up_b.astype(F32) + gk_bias_b.astype(F32)) / GLA_GATE_NORM, GLA_HEADS)
    return (rq, rk, rv, rg, gq, gk, gv, gg, la_f, la_b)


def bidir_mix(feats, lg_f, lg_b, states):
    rq, rk, rv, rg, gq, gk, gv, gg, la_f, la_b = feats
    s_rf, s_rb, s_gf, s_gb = states
    o_rf, s_rf = retention_scan(rq, rk, rv, lg_f, s_rf)
    o_rb, s_rb = retention_scan(flip_seq(rq), flip_seq(rk), flip_seq(rv), lg_b, s_rb)
    o_gf, s_gf = gla_scan(gq, gk, gv, la_f, s_gf)
    o_gb, s_gb = gla_scan(flip_seq(gq), flip_seq(gk), flip_seq(gv), flip_seq(la_b), s_gb)
    ret = head_rmsnorm(o_rf + flip_seq(o_rb)) * jax.nn.silu(rg)
    gla = head_rmsnorm(o_gf + flip_seq(o_gb)) * jax.nn.silu(gg)
    return jnp.concatenate([ret, gla], axis=-1), (s_rf, s_rb, s_gf, s_gb)


def context_final_states(feats, lg_f, lg_b):
    _, rk, rv, _, _, gk, gv, _, la_f, la_b = feats
    return (retention_final_state(rk, rv, lg_f),
            retention_final_state(flip_seq(rk), flip_seq(rv), lg_b),
            gla_final_state(gk, gv, la_f),
            gla_final_state(flip_seq(gk), flip_seq(gv), flip_seq(la_b)))


def zero_states(b):
    return (jnp.zeros((b, RET_HEADS, RET_DK, RET_DV), F32),
            jnp.zeros((b, RET_HEADS, RET_DK, RET_DV), F32),
            jnp.zeros((b, GLA_HEADS, GLA_DK, GLA_DV), F32),
            jnp.zeros((b, GLA_HEADS, GLA_DK, GLA_DV), F32))


def peer_ffn(h, w_q, k1, k2, down, up):
    B, L, D = h.shape
    half = PEER_DQ // 2
    blocks = h.reshape(-1, PEER_BLOCK, D)

    def block(xb):
        q = (xb @ w_q).astype(F32).reshape(PEER_BLOCK, PEER_HEADS, 2, half)
        s1 = jnp.einsum("thd,hnd->thn", q[:, :, 0], k1.astype(F32))
        s2 = jnp.einsum("thd,hnd->thn", q[:, :, 1], k2.astype(F32))
        v1, i1 = lax.top_k(s1, PEER_TOPK)
        v2, i2 = lax.top_k(s2, PEER_TOPK)
        cand_s = (v1[..., :, None] + v2[..., None, :]).reshape(PEER_BLOCK, PEER_HEADS, PEER_TOPK * PEER_TOPK)
        cand_i = (i1[..., :, None] * N_KEYS + i2[..., None, :]).reshape(PEER_BLOCK, PEER_HEADS, PEER_TOPK * PEER_TOPK)
        top_s, pos = lax.top_k(cand_s, PEER_TOPK)
        idx = jnp.take_along_axis(cand_i, pos, axis=-1)
        g = jax.nn.softmax(top_s, axis=-1)
        u = down[idx]
        act = jax.nn.gelu(jnp.einsum("thkd,td->thk", u, xb).astype(F32), approximate=False)
        return jnp.einsum("thk,thkd->td", (g * act).astype(xb.dtype), up[idx])

    return lax.map(block, blocks).reshape(B, L, D)


def trunk_layer(x, xc, c, c_ctx, w_mod, b_mod, norm1_w, norm2_w, w_in,
                ret_decay_f, ret_decay_b, gk_up_f, gk_bias_f, gk_up_b, gk_bias_b,
                w_out, peer_w_q, peer_k1, peer_k2, peer_down, peer_up, rope, update_ctx):
    mod = (jax.nn.silu(c) @ w_mod + b_mod)[:, None, :]
    mod_c = (jax.nn.silu(c_ctx) @ w_mod + b_mod)[None, None, :]
    sh1, sc1, g1, sh2, sc2, g2 = jnp.split(mod, N_MOD, axis=-1)
    csh1, csc1, cg1, csh2, csc2, cg2 = jnp.split(mod_c, N_MOD, axis=-1)
    lg_f = jax.nn.log_sigmoid(ret_decay_f.astype(F32))
    lg_b = jax.nn.log_sigmoid(ret_decay_b.astype(F32))

    feats_c = project(modulate(rmsnorm(xc, norm1_w), csh1, csc1),
                      w_in, gk_up_f, gk_bias_f, gk_up_b, gk_bias_b, None)
    if update_ctx:
        yc, ctx_states = bidir_mix(feats_c, lg_f, lg_b, zero_states(xc.shape[0]))
    else:
        ctx_states = context_final_states(feats_c, lg_f, lg_b)

    feats = project(modulate(rmsnorm(x, norm1_w), sh1, sc1),
                    w_in, gk_up_f, gk_bias_f, gk_up_b, gk_bias_b, rope)
    y, _ = bidir_mix(feats, lg_f, lg_b, ctx_states)
    x = x + g1 * (y.astype(x.dtype) @ w_out)
    x = x + g2 * peer_ffn(modulate(rmsnorm(x, norm2_w), sh2, sc2),
                          peer_w_q, peer_k1, peer_k2, peer_down, peer_up)
    if update_ctx:
        xc = xc + cg1 * (yc.astype(xc.dtype) @ w_out)
        xc = xc + cg2 * peer_ffn(modulate(rmsnorm(xc, norm2_w), csh2, csc2),
                                 peer_w_q, peer_k1, peer_k2, peer_down, peer_up)
    return x, xc


def setup_inputs(seed: int = 0) -> dict:
    key = jax.random.key(seed)
    ks = jax.random.split(key, 24)

    def nrm(k, shape, s):
        return jax.random.normal(k, shape, F32) * s

    base_logit = jnp.asarray(np.log(2.0 ** (5 + np.arange(RET_HEADS)) - 1.0), F32)[None, :]
    return {
        "x": nrm(ks[0], (BATCH, SEQ, D_MODEL), 1.0),
        "c": nrm(ks[1], (BATCH, D_MODEL), 1.0),
        "ctx": nrm(ks[2], (BATCH, CTX_LEN, D_MODEL), 1.0),
        "c_ctx": nrm(ks[3], (D_MODEL,), 1.0),
        "w_mod": nrm(ks[4], (DEPTH, D_MODEL, N_MOD * D_MODEL), 0.5 * D_MODEL ** -0.5),
        "b_mod": nrm(ks[5], (DEPTH, N_MOD * D_MODEL), 0.02),
        "norm1_w": 1.0 + nrm(ks[6], (DEPTH, D_MODEL), 0.02),
        "norm2_w": 1.0 + nrm(ks[7], (DEPTH, D_MODEL), 0.02),
        "w_in": nrm(ks[8], (DEPTH, D_MODEL, IN_COLS), D_MODEL ** -0.5),
        "ret_decay_f": base_logit + nrm(ks[9], (DEPTH, RET_HEADS), 0.05),
        "ret_decay_b": base_logit + nrm(ks[10], (DEPTH, RET_HEADS), 0.05),
        "gla_gk_up_f": nrm(ks[11], (DEPTH, GLA_RANK, GLA_HEADS * GLA_DK), GLA_RANK ** -0.5),
        "gla_gk_bias_f": nrm(ks[12], (DEPTH, GLA_HEADS * GLA_DK), 0.1),
        "gla_gk_up_b": nrm(ks[13], (DEPTH, GLA_RANK, GLA_HEADS * GLA_DK), GLA_RANK ** -0.5),
        "gla_gk_bias_b": nrm(ks[14], (DEPTH, GLA_HEADS * GLA_DK), 0.1),
        "w_out": nrm(ks[15], (DEPTH, D_MIX, D_MODEL), D_MIX ** -0.5),
        "peer_w_q": nrm(ks[16], (DEPTH, D_MODEL, PEER_HEADS * PEER_DQ), D_MODEL ** -0.5),
        "peer_k1": nrm(ks[17], (DEPTH, PEER_HEADS, N_KEYS, PEER_DQ // 2), (PEER_DQ // 2) ** -0.5),
        "peer_k2": nrm(ks[18], (DEPTH, PEER_HEADS, N_KEYS, PEER_DQ // 2), (PEER_DQ // 2) ** -0.5),
        "peer_down": nrm(ks[19], (DEPTH, N_EXPERTS, D_MODEL), D_MODEL ** -0.5),
        "peer_up": nrm(ks[20], (DEPTH, N_EXPERTS, D_MODEL), 0.5),
        "norm_f_w": 1.0 + nrm(ks[21], (D_MODEL,), 0.02),
    }


def reference(x, c, ctx, c_ctx, w_mod, b_mod, norm1_w, norm2_w, w_in,
              ret_decay_f, ret_decay_b, gla_gk_up_f, gla_gk_bias_f, gla_gk_up_b, gla_gk_bias_b,
              w_out, peer_w_q, peer_k1, peer_k2, peer_down, peer_up, norm_f_w):
    L = x.shape[1]
    ROWS = L // GRID_W
    rope = axial_rope(ROWS, GRID_W)
    xc = ctx
    for li in range(DEPTH):
        x, xc = trunk_layer(x, xc, c, c_ctx, w_mod[li], b_mod[li], norm1_w[li], norm2_w[li], w_in[li],
                            ret_decay_f[li], ret_decay_b[li], gla_gk_up_f[li], gla_gk_bias_f[li],
                            gla_gk_up_b[li], gla_gk_bias_b[li], w_out[li], peer_w_q[li],
                            peer_k1[li], peer_k2[li], peer_down[li], peer_up[li], rope,
                            li < DEPTH - 1)
    return rmsnorm(x, norm_f_w)
```

```cpp
#include <hip/hip_runtime.h>
#include <cstdio>
#include <cstdint>

typedef short bf16x8 __attribute__((ext_vector_type(8)));
typedef float f32x16 __attribute__((ext_vector_type(16)));
typedef float f32x4 __attribute__((ext_vector_type(4)));
typedef float f32x2 __attribute__((ext_vector_type(2)));
typedef unsigned u32x4 __attribute__((ext_vector_type(4)));
typedef unsigned u32x2 __attribute__((ext_vector_type(2)));
typedef unsigned short u16;

#ifndef N_LAUNCH_SPLIT
#define N_LAUNCH_SPLIT 0
#endif

constexpr int D = 1024, NBATCH = 2, SEQ = 8192, CTXL = 256;
constexpr int T_LAT = NBATCH * SEQ;
constexpr int T_ALL = T_LAT + NBATCH * CTXL;
constexpr int NIN = 3616, NIN_PAD = 3840;
constexpr int PITCH = 1088;
constexpr int NTHREADS = 512, NWAVES = 8;
constexpr int LDS_BYTES = 132 * 1024;
constexpr int NPHASES = 14;

constexpr size_t OFF_CTL = 0;
constexpr size_t CTL_BYTES = 16 * 1024;
constexpr size_t OFF_MOD = 64 * 1024;
constexpr size_t OFF_TABR = 192 * 1024;
constexpr size_t OFF_TABC = 224 * 1024;
constexpr size_t OFF_WIN = 256 * 1024;
constexpr size_t OFF_WOUT = OFF_WIN + (size_t)NIN_PAD * PITCH * 2;
constexpr size_t OFF_WQ = OFF_WOUT + (size_t)1024 * PITCH * 2;
constexpr size_t OFF_K1 = OFF_WQ + (size_t)2048 * PITCH * 2;
constexpr size_t OFF_K2 = OFF_K1 + (size_t)8 * 128 * 128 * 2;
constexpr size_t OFF_FEAT = OFF_K2 + (size_t)8 * 128 * 128 * 2;
constexpr size_t PL512 = (size_t)T_ALL * 512 * 2, PL256 = (size_t)T_ALL * 256 * 2;
constexpr size_t OFF_RQ = OFF_FEAT, OFF_RK = OFF_RQ + PL512, OFF_RKT = OFF_RK + PL512, OFF_RVT = OFF_RKT + PL512, OFF_RG = OFF_RVT + PL512;
constexpr size_t OFF_GQ = OFF_RG + PL512, OFF_GK = OFF_GQ + PL256, OFF_GKT = OFF_GK + PL256, OFF_GVT = OFF_GKT + PL256, OFF_GG = OFF_GVT + PL512;
constexpr size_t OFF_LR = OFF_GG + PL512;
constexpr size_t OFF_O = OFF_LR + (size_t)T_ALL * 32 * 4;
constexpr size_t OPL = (size_t)T_LAT * 512 * 2;
constexpr size_t OFF_ORF = OFF_O, OFF_ORB = OFF_ORF + OPL, OFF_OGF = OFF_ORB + OPL, OFF_OGB = OFF_OGF + OPL;
constexpr size_t OFF_H = OFF_O;
constexpr size_t OFF_Y = OFF_RQ;
constexpr size_t OFF_SLOT_R = OFF_OGB + OPL;
constexpr size_t OFF_SLOT_G = OFF_SLOT_R + (size_t)16 * 16 * 65536;
constexpr size_t OFF_GSUM = OFF_SLOT_G + (size_t)16 * 16 * 32768;
constexpr size_t WS_END_A = OFF_GSUM + 65536;
constexpr size_t OFF_H2 = OFF_FEAT;
constexpr size_t OFF_QB = OFF_H2 + (size_t)T_LAT * PITCH * 2;
constexpr size_t OFF_IDX = OFF_QB;
constexpr size_t OFF_GW = OFF_IDX + (size_t)T_LAT * 128 * 4;
constexpr size_t OFF_X1 = OFF_GW + (size_t)T_LAT * 128 * 4;
constexpr size_t OFF_UPB = OFF_X1 + (size_t)16384 * 1024 * 2;
constexpr size_t DOUT_DOWN = 0, DOUT_UP = (size_t)16384 * 1024, DOUT_DSC = (size_t)2 * 16384 * 1024;
constexpr size_t OFF_COEF = OFF_UPB + (size_t)16384 * 1024 * 2;
constexpr size_t OFF_SSQ = OFF_COEF + (size_t)T_LAT * 128 * 4;
constexpr size_t OFF_PART = OFF_SSQ + (size_t)T_LAT * 8 * 4;
constexpr size_t OFF_H2Q = OFF_PART + (size_t)8 * T_LAT * 128 * 2;
constexpr size_t OFF_HS = OFF_H2Q + (size_t)T_LAT * 1024;
constexpr size_t OFF_DSC = OFF_HS + (size_t)T_LAT * 4;
constexpr size_t WS_END_B = OFF_DSC + (size_t)16384 * 4;
constexpr size_t WS_NEED = WS_END_A > WS_END_B ? WS_END_A : WS_END_B;
static_assert(WS_NEED <= (size_t)256 * 1024 * 1024, "workspace map exceeds the guaranteed 256 MiB");
static_assert((size_t)T_ALL * PITCH * 2 <= 4 * OPL && (size_t)T_LAT * PITCH * 2 <= 3 * PL512, "H / Y aliases");

constexpr float UP_SCALE = 64.f;
__device__ const double ROPE_INV[32] = {1.0, 0.7498942093324559, 0.5623413251903491, 0.4216965034285822, 0.31622776601683794, 0.23713737056616552, 0.1778279410038923, 0.1333521432163324, 0.1, 0.07498942093324558, 0.05623413251903491, 0.042169650342858224, 0.03162277660168379, 0.023713737056616554, 0.01778279410038923, 0.01333521432163324, 0.01, 0.007498942093324558, 0.005623413251903491, 0.004216965034285823, 0.0031622776601683794, 0.0023713737056616554, 0.0017782794100389228, 0.001333521432163324, 0.001, 0.0007498942093324559, 0.0005623413251903491, 0.00042169650342858224, 0.00031622776601683794, 0.00023713737056616554, 0.00017782794100389227, 0.0001333521432163324};

struct Args { const float* in[22]; float* out; unsigned char* ws; int ph_lo, ph_hi; int rep, pad; };

__device__ __forceinline__ int lane_id_asm() { int x; asm volatile("v_mbcnt_lo_u32_b32 %0, -1, 0\n\tv_mbcnt_hi_u32_b32 %0, -1, %0" : "=v"(x)); return x; }
__device__ __forceinline__ int opaque_i(int x) { asm volatile("" : "+v"(x)); return x; }
typedef __bf16 bf16x2_t __attribute__((ext_vector_type(2)));
__device__ __forceinline__ unsigned pk2(float lo, float hi) { f32x2 f; f.x = lo; f.y = hi; const bf16x2_t v = __builtin_convertvector(f, bf16x2_t); return __builtin_bit_cast(unsigned, v); }
typedef _Float16 f16x2_t __attribute__((ext_vector_type(2)));
__device__ __forceinline__ unsigned pkh2(float a, float b) { f32x2 v; v.x = a; v.y = b; const f16x2_t h = __builtin_convertvector(v, f16x2_t); return __builtin_bit_cast(unsigned, h); }
__device__ __forceinline__ f32x2 unpkh2(unsigned u) { const f16x2_t h = __builtin_bit_cast(f16x2_t, u); return __builtin_convertvector(h, f32x2); }
__device__ __forceinline__ float bf_lo(unsigned u) { return __uint_as_float(u << 16); }
__device__ __forceinline__ float bf_hi(unsigned u) { return __uint_as_float(u & 0xffff0000u); }
__device__ __forceinline__ u16 bf1(float x) { return (u16)(pk2(x, 0.f) & 0xffffu); }
__device__ __forceinline__ float wave_max(float v) {
#pragma unroll
    for (int o = 1; o < 64; o <<= 1) v = fmaxf(v, __shfl_xor(v, o));
    return v;
}
__device__ __forceinline__ unsigned q8x4(float a, float b, float c, float d, float sc) {
    const int ia = (int)rintf(a * sc), ib = (int)rintf(b * sc), ic = (int)rintf(c * sc), id = (int)rintf(d * sc);
    return ((unsigned)ia & 0xffu) | (((unsigned)ib & 0xffu) << 8) | (((unsigned)ic & 0xffu) << 16) | ((unsigned)id << 24);
}
__device__ __forceinline__ float wave_sum(float v) {
#pragma unroll
    for (int o = 1; o < 64; o <<= 1) v += __shfl_xor(v, o);
    return v;
}
__device__ __forceinline__ float silu_f(float x) { return x / (1.f + expf(-x)); }
__device__ __forceinline__ float logsig_f(float x) { return fminf(x, 0.f) - log1pf(expf(-fabsf(x))); }
__device__ __forceinline__ float logsig_fast(float x) { return fminf(x, 0.f) - __logf(1.f + __expf(-fabsf(x))); }
__device__ __forceinline__ float silu_fast(float x) { return x * __builtin_amdgcn_rcpf(1.f + __expf(-x)); }
#define MFMA(a, b, c) __builtin_amdgcn_mfma_f32_32x32x16_bf16((a), (b), (c), 0, 0, 0)
__device__ __forceinline__ int acc_row(int r, int hh) { return (r & 3) + 8 * (r >> 2) + 4 * hh; }

__device__ __forceinline__ int off128(int r, int c) { return r * 128 + ((c ^ ((r >> 1) & 7)) << 4); }
__device__ __forceinline__ int off256(int r, int c) { return r * 256 + ((c ^ (r & 15)) << 4); }

#define XB_TMO      128
#define XB_XCNT(j)  (256  + 64 * (j))
#define XB_XSUB(j)  (1280 + 64 * (j))
#define XB_XGEN(j)  (2304 + 64 * (j))
#define XB_TOP      3328
#define XB_TOPGEN   3392
#define XCD_BAR_WORDS 3456
#define XB_MODCNT   3520
#define XB_SPIN_CAP (1u << 22)
__device__ __forceinline__ unsigned xb_ld(unsigned* p)              { return __hip_atomic_load(p, __ATOMIC_RELAXED, __HIP_MEMORY_SCOPE_AGENT); }
__device__ __forceinline__ unsigned xb_add(unsigned* p, unsigned v) { return __hip_atomic_fetch_add(p, v, __ATOMIC_RELAXED, __HIP_MEMORY_SCOPE_AGENT); }
__device__ __forceinline__ unsigned xb_xcc_id() { return (unsigned)__builtin_amdgcn_s_getreg((3 << 11) | 20) & 0xFu; }
#define XB_SPIN(cond, bar) do { unsigned _sp = 0; while (cond) { __builtin_amdgcn_s_sleep(1); \
    if ((++_sp & 255u) == 0u) { if (xb_ld(&(bar)[XB_TMO])) break; if (_sp > XB_SPIN_CAP) { atomicAdd(&(bar)[XB_TMO], 1u); break; } } } } while (0)
struct XcdBarrier { unsigned* bar; unsigned x; volatile unsigned* st; };
__device__ __forceinline__ XcdBarrier xcd_barrier_post(unsigned* bar, volatile unsigned* st) {
    XcdBarrier b; b.bar = bar; b.x = xb_xcc_id(); b.st = st;
    if (threadIdx.x == 0) (void)xb_add(&bar[XB_XCNT(b.x)], 1u);
    return b;
}
__device__ __forceinline__ void xcd_barrier_complete(unsigned* bar, unsigned x, unsigned& nloc, unsigned& nx) {
    const unsigned G = gridDim.x * gridDim.y * gridDim.z;
    unsigned sum, cnt, mine, sp = 0u;
    for (;;) {
        sum = 0u; cnt = 0u; mine = 0u;
#pragma unroll
        for (unsigned j = 0; j < 16; ++j) { const unsigned c = xb_ld(&bar[XB_XCNT(j)]); sum += c; cnt += (c > 0u) ? 1u : 0u; mine = (j == x) ? c : mine; }
        if (sum == G) break;
        __builtin_amdgcn_s_sleep(1);
        if ((++sp & 255u) == 0u) { if (xb_ld(&bar[XB_TMO])) break; if (sp > XB_SPIN_CAP) { atomicAdd(&bar[XB_TMO], 1u); break; } }
    }
    nloc = mine > 0u ? mine : 1u; nx = cnt > 0u ? cnt : 1u;
}
__device__ __forceinline__ void xcd_barrier(const XcdBarrier& b) {
    asm volatile("s_waitcnt vmcnt(0)" ::: "memory");
    __syncthreads();
    if (threadIdx.x == 0) {
        unsigned* bar = b.bar;
        __builtin_amdgcn_s_waitcnt(0);
        unsigned nloc = b.st[0], nx = b.st[1];
        if (nloc == 0u) { xcd_barrier_complete(bar, b.x, nloc, nx); b.st[0] = nloc; b.st[1] = nx; }
        const unsigned old = xb_add(&bar[XB_XSUB(b.x)], 1u);
        const unsigned gen = old / nloc;
        if (old + 1u == (gen + 1u) * nloc) {
            __builtin_amdgcn_fence(__ATOMIC_RELEASE, "agent");
            asm volatile("s_waitcnt vmcnt(0)" ::: "memory");
            const unsigned og = xb_add(&bar[XB_TOP], 1u);
            const unsigned tg = og / nx;
            if (og + 1u == (tg + 1u) * nx) xb_add(&bar[XB_TOPGEN], 1u);
            else XB_SPIN(xb_ld(&bar[XB_TOPGEN]) == tg, bar);
            __builtin_amdgcn_fence(__ATOMIC_ACQUIRE, "agent");
            xb_add(&bar[XB_XGEN(b.x)], 1u);
            asm volatile("s_waitcnt vmcnt(0)" ::: "memory");
        } else {
            XB_SPIN(xb_ld(&bar[XB_XGEN(b.x)]) == gen, bar);
            __builtin_amdgcn_fence(__ATOMIC_ACQUIRE, "agent");
            asm volatile("s_waitcnt vmcnt(0)" ::: "memory");
        }
    }
    __syncthreads();
}

constexpr int NGEMV = 192;
__device__ __forceinline__ void transpose_item64(const float* W, int N, int nvalid, int n0, u16* WT, int k0, int lane) {
    const int n = n0 + lane; const bool ok = n < nvalid; const int nl = ok ? n : 0;
    float v[64];
#pragma unroll
    for (int i = 0; i < 64; ++i) { const float* rowp = W + (size_t)(k0 + i) * N; v[i] = rowp[nl]; }
    u32x4* o = (u32x4*)(WT + (size_t)n * PITCH + k0);
#pragma unroll
    for (int j = 0; j < 8; ++j) { u32x4 q; q.x = pk2(v[8 * j], v[8 * j + 1]); q.y = pk2(v[8 * j + 2], v[8 * j + 3]); q.z = pk2(v[8 * j + 4], v[8 * j + 5]); q.w = pk2(v[8 * j + 6], v[8 * j + 7]);
        if (!ok) { q.x = 0u; q.y = 0u; q.z = 0u; q.w = 0u; }
        o[j] = q; }
}
__device__ __forceinline__ void sincos_d(double a, float& c, float& s) {
    const double TWO_PI = 6.283185307179586476925287;
    a -= rint(a / TWO_PI) * TWO_PI;
    const double x2 = a * a;
    double sc = 1.0, ss = 1.0;
#pragma unroll
    for (int k = 15; k >= 1; --k) { sc = 1.0 - sc * x2 / (double)((2 * k - 1) * (2 * k)); ss = 1.0 - ss * x2 / (double)((2 * k) * (2 * k + 1)); }
    c = (float)sc; s = (float)(ss * a);
}
__device__ __forceinline__ void phase0(const Args& A, unsigned char* lds, int bid, int G, int tid) {
    const int lane = tid & 63, wave = tid >> 6;
    const float* c = A.in[1]; const float* c_ctx = A.in[3]; const float* w_mod = A.in[4]; const float* b_mod = A.in[5];
    float* mod = (float*)(A.ws + OFF_MOD);
    if (bid < NGEMV) {
        float* sv = (float*)lds;
        float* red = sv + 3072;
        for (int i = tid; i < 3072; i += NTHREADS) { const int v = i >> 10, k = i & 1023; const float x = (v < 2) ? c[v * 1024 + k] : c_ctx[k]; sv[i] = silu_f(x); }
        const int c0 = bid * 32, kr = lane >> 3, cq = (lane & 7) * 4;
        const float* wp = w_mod + (size_t)(wave * 128 + kr) * 6144 + c0 + cq;
        f32x4 wv[16];
#pragma unroll
        for (int i = 0; i < 16; ++i) wv[i] = *(const f32x4*)(wp + (size_t)(8 * i) * 6144);
        __syncthreads();
        f32x4 a0 = {0.f, 0.f, 0.f, 0.f}, a1 = a0, a2 = a0;
#pragma unroll
        for (int i = 0; i < 16; ++i) { const int kk = wave * 128 + 8 * i + kr; a0 += wv[i] * sv[kk]; a1 += wv[i] * sv[1024 + kk]; a2 += wv[i] * sv[2048 + kk]; }
#pragma unroll
        for (int m = 8; m < 64; m <<= 1) {
            a0.x += __shfl_xor(a0.x, m); a0.y += __shfl_xor(a0.y, m); a0.z += __shfl_xor(a0.z, m); a0.w += __shfl_xor(a0.w, m);
            a1.x += __shfl_xor(a1.x, m); a1.y += __shfl_xor(a1.y, m); a1.z += __shfl_xor(a1.z, m); a1.w += __shfl_xor(a1.w, m);
            a2.x += __shfl_xor(a2.x, m); a2.y += __shfl_xor(a2.y, m); a2.z += __shfl_xor(a2.z, m); a2.w += __shfl_xor(a2.w, m); }
        if (lane < 8) { *(f32x4*)(red + (wave * 3 + 0) * 32 + cq) = a0; *(f32x4*)(red + (wave * 3 + 1) * 32 + cq) = a1; *(f32x4*)(red + (wave * 3 + 2) * 32 + cq) = a2; }
        __syncthreads();
        if (tid < 96) { const int v = tid >> 5, l = tid & 31; float sacc = b_mod[c0 + l];
#pragma unroll
            for (int w = 0; w < 8; ++w) sacc += red[(w * 3 + v) * 32 + l];
            mod[v * 6144 + c0 + l] = sacc; }
        asm volatile("s_waitcnt vmcnt(0)" ::: "memory"); __syncthreads();
        if (tid == 0) { __builtin_amdgcn_fence(__ATOMIC_RELEASE, "agent"); (void)xb_add((unsigned*)(A.ws + OFF_CTL) + XB_MODCNT, 1u); }
    }
    {
        const int vb = bid >= NGEMV ? bid - NGEMV : bid + (G - NGEMV);
        constexpr int I_IN = 16 * (NIN_PAD / 64), I_OUT = 16 * 16, I_Q = 16 * 32;
        u16* win_t = (u16*)(A.ws + OFF_WIN); u16* wout_t = (u16*)(A.ws + OFF_WOUT); u16* wq_t = (u16*)(A.ws + OFF_WQ);
        for (int it = vb * NWAVES + wave; it < I_IN + I_OUT + I_Q; it += G * NWAVES) {
            int r = it;
            if (r < I_IN) { transpose_item64(A.in[8], NIN, NIN, (r % (NIN_PAD / 64)) * 64, win_t, (r / (NIN_PAD / 64)) * 64, lane); continue; }
            r -= I_IN;
            if (r < I_OUT) { transpose_item64(A.in[15], 1024, 1024, (r % 16) * 64, wout_t, (r / 16) * 64, lane); continue; }
            r -= I_OUT;
            transpose_item64(A.in[16], 2048, 2048, (r % 32) * 64, wq_t, (r / 32) * 64, lane);
        }
        const int gt = vb * NTHREADS + tid, NGT = G * NTHREADS;
        for (int i = gt; i < 2 * 16384; i += NGT) { const int which = i >> 14, ch = i & 16383; const int hh_ = ch & 1; const float* src = A.in[17 + which] + (size_t)(ch >> 1) * 16 + 4 * hh_;
            const f32x4 a = *(const f32x4*)src, b = *(const f32x4*)(src + 8); u32x4 o; o.x = pk2(a.x, a.y); o.y = pk2(a.z, a.w); o.z = pk2(b.x, b.y); o.w = pk2(b.z, b.w);
            *(u32x4*)(A.ws + (which ? OFF_K2 : OFF_K1) + (size_t)ch * 16) = o; }
        for (int i = gt - 64 * NTHREADS; i >= 0 && i < 192 * 32; i += NGT) { const int p = i >> 5, f = i & 31; float cs, sn; const int pos = p < 128 ? p : p - 128; sincos_d((double)pos * ROPE_INV[f], cs, sn);
            f32x2* t = (f32x2*)(A.ws + (p < 128 ? OFF_TABR : OFF_TABC)) + pos * 32 + f; f32x2 v; v.x = cs; v.y = sn; *t = v; }
    }
}

__device__ __forceinline__ int xcd_row(int i, int gw, int NGW) {
    const int bid = gw >> 3, wave = gw & 7, x = bid & 7, wl = (bid >> 3) * 8 + wave;
    const int ra = 2048 * x + wl + 256 * i, rb = 16384 + gw + 2048 * (i - 8), rc = gw + i * NGW;
    return (NGW == 2048) ? (i < 8 ? ra : rb) : rc;
}
template <bool Q8, bool BFIN>
__device__ __forceinline__ void norm_rows(const float* src_lat, const float* src_ctx, int nrows, const float* w, const float* mod, int shift_idx, int scale_idx, u16* dst, int gw, int NGW, int lane, unsigned char* q8 = nullptr, float* qs = nullptr, unsigned* ctl = nullptr) {
    const int niter_ = (NGW == 2048) ? (nrows > 16384 ? 9 : 8) : (nrows + NGW - 1) / NGW;
    f32x4 x[4], mul[4], shf[4]; u32x2 xb[4]; int vcur = -1;
    int r = xcd_row(0, gw, NGW);
    { const int rc = r < nrows ? r : nrows - 1;
      if (BFIN) { const u32x2* s2 = (const u32x2*)((const u16*)src_lat + (size_t)rc * D) + lane;
#pragma unroll
          for (int j = 0; j < 4; ++j) xb[j] = s2[64 * j]; }
      else { const f32x4* s4 = (const f32x4*)(rc < T_LAT ? src_lat + (size_t)rc * D : src_ctx + (size_t)(rc - T_LAT) * D) + lane;
#pragma unroll
          for (int j = 0; j < 4; ++j) x[j] = s4[64 * j]; } }
    for (int i_ = 0; i_ < niter_; ++i_) {
        const int rn = i_ + 1 < niter_ ? xcd_row(i_ + 1, gw, NGW) : nrows; f32x4 xn[4]; u32x2 xbn[4];
        { const int rc = rn < nrows ? rn : nrows - 1;
          if (BFIN) { const u32x2* s2 = (const u32x2*)((const u16*)src_lat + (size_t)rc * D) + lane;
#pragma unroll
              for (int j = 0; j < 4; ++j) xbn[j] = s2[64 * j]; }
          else { const f32x4* s4 = (const f32x4*)(rc < T_LAT ? src_lat + (size_t)rc * D : src_ctx + (size_t)(rc - T_LAT) * D) + lane;
#pragma unroll
              for (int j = 0; j < 4; ++j) xn[j] = s4[64 * j]; } }
        if (BFIN) {
#pragma unroll
            for (int j = 0; j < 4; ++j) { x[j].x = bf_lo(xb[j].x); x[j].y = bf_hi(xb[j].x); x[j].z = bf_lo(xb[j].y); x[j].w = bf_hi(xb[j].y); } }
        if (r < nrows) {
            const int v = r < T_LAT ? (r >> 13) : 2;
            if (v != vcur) {
                if (ctl != nullptr && vcur < 0) { if (threadIdx.x == 0) { XB_SPIN(xb_ld(&ctl[XB_MODCNT]) < (unsigned)NGEMV, ctl); __builtin_amdgcn_fence(__ATOMIC_ACQUIRE, "agent"); } __syncthreads(); }
                vcur = v; const f32x4* w4 = (const f32x4*)w + lane; const f32x4* sh4 = (const f32x4*)(mod + v * 6144 + shift_idx * 1024) + lane; const f32x4* sc4 = (const f32x4*)(mod + v * 6144 + scale_idx * 1024) + lane;
#pragma unroll
                for (int j = 0; j < 4; ++j) { mul[j] = w4[64 * j] * (sc4[64 * j] + 1.f); shf[j] = sh4[64 * j]; } }
            float ss = 0.f;
#pragma unroll
            for (int j = 0; j < 4; ++j) ss += (x[j].x * x[j].x + x[j].y * x[j].y) + (x[j].z * x[j].z + x[j].w * x[j].w);
            const float rstd = 1.f / sqrtf(wave_sum(ss) * (1.f / D) + 1e-6f);
            u32x2* o = (u32x2*)(dst + (size_t)r * PITCH) + lane; f32x4 y[4]; float mx = 0.f;
#pragma unroll
            for (int j = 0; j < 4; ++j) { y[j] = x[j] * rstd * mul[j] + shf[j];
                u32x2 p; p.x = pk2(y[j].x, y[j].y); p.y = pk2(y[j].z, y[j].w); o[64 * j] = p;
                if (Q8) mx = fmaxf(mx, fmaxf(fmaxf(fabsf(y[j].x), fabsf(y[j].y)), fmaxf(fabsf(y[j].z), fabsf(y[j].w)))); }
            if (Q8) {
                mx = fmaxf(wave_max(mx), 1e-20f); const float qsc = 127.f / mx; unsigned* qo = (unsigned*)(q8 + (size_t)r * D) + lane;
#pragma unroll
                for (int j = 0; j < 4; ++j) qo[64 * j] = q8x4(y[j].x, y[j].y, y[j].z, y[j].w, qsc);
                if (lane == 0) qs[r] = mx * (1.f / 127.f); }
        }
#pragma unroll
        for (int j = 0; j < 4; ++j) { if (BFIN) xb[j] = xbn[j]; else x[j] = xn[j]; }
        r = rn;
    }
}

#define RAW_BARRIER() do { __builtin_amdgcn_s_waitcnt(0xC07F)  ; asm volatile("" ::: "memory"); __builtin_amdgcn_s_barrier(); asm volatile("" ::: "memory"); } while (0)
template <class Epi>
__device__ __forceinline__ void gemm_phase(const u16* Ag_, const u16* Bg_, int Mtiles, int Ntiles, unsigned char* lds, const Epi& epi, int bid, int G, int tid) {
    const int lane = tid & 63, wave = __builtin_amdgcn_readfirstlane(tid >> 6), wm = wave >> 1, wn = wave & 1, l31 = lane & 31, hh = lane >> 5;
    const bool xo = (G == 256); const int xcd = bid & 7, jx = bid >> 3, mper = Mtiles >> 3, nmain = xo ? mper * Ntiles : Mtiles * Ntiles, nextra = xo ? (Mtiles - mper * 8) * Ntiles : 0;
    const int srow = wave * 32 + (lane >> 2), sc = ((lane & 3) ^ ((lane >> 4) & 3)) * 8;
    const int fsw = (l31 >> 2) & 3;
    const int koff = xo ? 2 * (((jx & 7) + (jx >> 3)) & 3) : 0;
    for (int q = xo ? jx : bid; q < nmain + ((nextra + 7) >> 3); q += xo ? 32 : G) {
        int mt, nt;
        if (!xo) { mt = q / Ntiles; nt = q % Ntiles; }
        else if (q < nmain) { mt = xcd * mper + q % mper; nt = q / mper; }
        else { const int e = (q - nmain) * 8 + xcd; if (e >= nextra) continue; mt = mper * 8 + e / Ntiles; nt = e % Ntiles; }
        const int so_ = opaque_i(srow * PITCH + sc);
        const u16* Ag = Ag_ + (size_t)mt * (256 * PITCH) + so_; const u16* Bg = Bg_ + (size_t)nt * (256 * PITCH) + so_;
        f32x16 acc[4][2];
#pragma unroll
        for (int i = 0; i < 4; ++i)
#pragma unroll
            for (int j = 0; j < 2; ++j)
#pragma unroll
                for (int r = 0; r < 16; ++r) acc[i][j][r] = 0.f;
        asm volatile("s_waitcnt vmcnt(0)" ::: "memory");
#define GEMM_ISSUE(kt_) do { unsigned char* st_ = lds + ((kt_) & 3) * 32768 + wave * 2048; \
        __builtin_amdgcn_global_load_lds((const unsigned*)(Ag + (((kt_) + koff) & 31) * 32), (__attribute__((address_space(3))) unsigned*)(st_), 16, 0, 0); \
        __builtin_amdgcn_global_load_lds((const unsigned*)(Ag + (((kt_) + koff) & 31) * 32 + 16 * PITCH), (__attribute__((address_space(3))) unsigned*)(st_ + 1024), 16, 0, 0); \
        __builtin_amdgcn_global_load_lds((const unsigned*)(Bg + (((kt_) + koff) & 31) * 32), (__attribute__((address_space(3))) unsigned*)(st_ + 16384), 16, 0, 0); \
        __builtin_amdgcn_global_load_lds((const unsigned*)(Bg + (((kt_) + koff) & 31) * 32 + 16 * PITCH), (__attribute__((address_space(3))) unsigned*)(st_ + 16384 + 1024), 16, 0, 0); } while (0)
        GEMM_ISSUE(0); GEMM_ISSUE(1); GEMM_ISSUE(2);
#define GEMM_LOADF(F_, kt_, ks_) do { const unsigned char* Ac_ = lds + ((kt_) & 3) * 32768; const unsigned char* Bc_ = Ac_ + 16384; const int co_ = ((((ks_) * 2 + hh) ^ fsw) << 4); \
        _Pragma("unroll") for (int tm = 0; tm < 2; ++tm) F_##a[tm] = *(const bf16x8*)(Ac_ + (wm * 64 + tm * 32 + l31) * 64 + co_); \
        _Pragma("unroll") for (int tn = 0; tn < 4; ++tn) F_##b[tn] = *(const bf16x8*)(Bc_ + (wn * 128 + tn * 32 + l31) * 64 + co_); } while (0)
#define GEMM_MFMA(F_) do { _Pragma("unroll") for (int tn = 0; tn < 4; ++tn) _Pragma("unroll") for (int tm = 0; tm < 2; ++tm) acc[tn][tm] = MFMA(F_##b[tn], F_##a[tm], acc[tn][tm]); } while (0)
        bf16x8 F0a[2], F0b[4], F1a[2], F1b[4], F2a[2], F2b[4];
        asm volatile("s_waitcnt vmcnt(8)" ::: "memory"); RAW_BARRIER();
        GEMM_LOADF(F0, 0, 0);
#define LDA_(F_, tm_, kt_, ks_) F_##a[tm_] = *(const bf16x8*)(lds + ((kt_) & 3) * 32768 + (wm * 64 + (tm_) * 32 + l31) * 64 + ((((ks_) * 2 + hh) ^ fsw) << 4))
#define LDB_(F_, tn_, kt_, ks_) F_##b[tn_] = *(const bf16x8*)(lds + ((kt_) & 3) * 32768 + 16384 + (wn * 128 + (tn_) * 32 + l31) * 64 + ((((ks_) * 2 + hh) ^ fsw) << 4))
#define MF_(F_, tn_, tm_) acc[tn_][tm_] = MFMA(F_##b[tn_], F_##a[tm_], acc[tn_][tm_])
#define SB_() __builtin_amdgcn_sched_barrier(0)
#define GEMM_STEP(CUR, NXT, kt_) do { \
            if ((kt_) < 31) { if ((kt_) < 30) asm volatile("s_waitcnt vmcnt(4)" ::: "memory"); else asm volatile("s_waitcnt vmcnt(0)" ::: "memory"); \
                RAW_BARRIER(); if ((kt_) + 3 < 32 && wave < 4) GEMM_ISSUE((kt_) + 3); } \
            SB_(); LDA_(F1, 0, kt_, 1); LDB_(F1, 0, kt_, 1); SB_(); MF_(CUR, 0, 0); SB_(); \
            LDA_(F1, 1, kt_, 1); LDB_(F1, 1, kt_, 1); SB_(); MF_(CUR, 0, 1); SB_(); \
            LDB_(F1, 2, kt_, 1); LDB_(F1, 3, kt_, 1); SB_(); MF_(CUR, 1, 0); SB_(); \
            if ((kt_) < 31) { LDA_(NXT, 0, (kt_) + 1, 0); LDB_(NXT, 0, (kt_) + 1, 0); } SB_(); MF_(CUR, 1, 1); SB_(); \
            if ((kt_) < 31) { LDA_(NXT, 1, (kt_) + 1, 0); LDB_(NXT, 1, (kt_) + 1, 0); } SB_(); MF_(CUR, 2, 0); SB_(); \
            if ((kt_) < 31) { LDB_(NXT, 2, (kt_) + 1, 0); LDB_(NXT, 3, (kt_) + 1, 0); } SB_(); MF_(CUR, 2, 1); MF_(CUR, 3, 0); MF_(CUR, 3, 1); SB_(); \
            MF_(F1, 0, 0); MF_(F1, 0, 1); MF_(F1, 1, 0); MF_(F1, 1, 1); SB_(); \
            if ((kt_) + 3 < 32 && wave >= 4) GEMM_ISSUE((kt_) + 3); SB_(); \
            MF_(F1, 2, 0); MF_(F1, 2, 1); MF_(F1, 3, 0); MF_(F1, 3, 1); SB_(); } while (0)
        for (int kt = 0; kt < 32; kt += 2) { GEMM_STEP(F0, F2, kt); GEMM_STEP(F2, F0, kt + 1); }
        __syncthreads();
        epi(acc, mt, nt, wm, wn, l31, hh, lds, tid);
    }
}

struct EpiIn {
    unsigned char* ws;
    __device__ __forceinline__ void operator()(f32x16 (&acc)[4][2], int mt, int nt, int wm_, int wn_, int l31_, int hh_, unsigned char* lds, int tid_) const {
        const int wm = opaque_i(wm_), wn = opaque_i(wn_), l31 = opaque_i(l31_), hh = opaque_i(hh_), tid = opaque_i(tid_);
        u16* RQ = (u16*)(ws + OFF_RQ); u16* RK = (u16*)(ws + OFF_RK); u16* RKT = (u16*)(ws + OFF_RKT); u16* RVT = (u16*)(ws + OFF_RVT); u16* RG = (u16*)(ws + OFF_RG);
        u16* GQ = (u16*)(ws + OFF_GQ); u16* GK = (u16*)(ws + OFF_GK); u16* GKT = (u16*)(ws + OFF_GKT); u16* GVT = (u16*)(ws + OFF_GVT); u16* GG = (u16*)(ws + OFF_GG);
        float* LR = (float*)(ws + OFF_LR);
        const int lane = tid & 63; unsigned char* wl = lds + (tid >> 6) * 16384;
        const int m0 = mt * 256 + wm * 64;
        const bool lat = m0 < T_LAT;
        const int nb = nt * 2 + wn;
        auto put_nat = [&](int tn, int tm, int g, u32x2 p) { const int m = tm * 32 + l31; *(u32x2*)(wl + m * 256 + (((tn * 4 + g) ^ (m & 15)) << 4) + hh * 8) = p; };
        auto put_tr = [&](int tn, int tm, int g, u32x2 p) { u16* t = (u16*)(wl + (tn * 32 + 8 * g + 4 * hh) * 128 + (tm * 32 + l31) * 2);
            t[0] = (u16)(p.x & 0xffffu); t[64] = (u16)(p.x >> 16); t[128] = (u16)(p.y & 0xffffu); t[192] = (u16)(p.y >> 16); };
        auto flush_nat = [&](u16* plane, int ld, int col0) {
            asm volatile("s_waitcnt lgkmcnt(0)" ::: "memory"); __builtin_amdgcn_wave_barrier();
#pragma unroll
            for (int i = 0; i < 16; ++i) { const int m = i * 4 + (lane >> 4), ch = lane & 15; const u32x4 v = *(const u32x4*)(wl + m * 256 + ((ch ^ (m & 15)) << 4));
                *(u32x4*)(plane + (size_t)(m0 + m) * ld + col0 + ch * 8) = v; }
            asm volatile("s_waitcnt lgkmcnt(0)" ::: "memory"); __builtin_amdgcn_wave_barrier(); };
        auto flush_tr = [&](u16* planeT, int row0) {
            asm volatile("s_waitcnt lgkmcnt(0)" ::: "memory"); __builtin_amdgcn_wave_barrier();
#pragma unroll
            for (int i = 0; i < 16; ++i) { const int n = i * 8 + (lane >> 3), ch = lane & 7; const u32x4 v = *(const u32x4*)(wl + n * 128 + ch * 16);
                *(u32x4*)(planeT + (size_t)(row0 + n) * T_ALL + m0 + ch * 8) = v; }
            asm volatile("s_waitcnt lgkmcnt(0)" ::: "memory"); __builtin_amdgcn_wave_barrier(); };
        if (nb < 8) {
            const int head = nb & 3; const bool isK = nb >= 4; const float s = isK ? 0.08838834764831845f : 1.f;
            const f32x2* tabR = (const f32x2*)(ws + OFF_TABR); const f32x2* tabC = (const f32x2*)(ws + OFF_TABC);
#pragma unroll
            for (int tm = 0; tm < 2; ++tm) {
                const int m = m0 + tm * 32 + l31; const int l = m & (SEQ - 1);
#pragma unroll
                for (int tn = 0; tn < 2; ++tn) {
                    const f32x2* tab = (tn == 0) ? tabR + (l >> 6) * 32 : tabC + (l & 63) * 32;
#pragma unroll
                    for (int r = 0; r < 16; ++r) { const float a = acc[tn][tm][r] * s, b = acc[tn + 2][tm][r] * s;
                        if (lat) { const f32x2 cs = tab[acc_row(r, hh)]; acc[tn][tm][r] = a * cs.x - b * cs.y; acc[tn + 2][tm][r] = b * cs.x + a * cs.y; } else { acc[tn][tm][r] = a; acc[tn + 2][tm][r] = b; } }
                }
            }
#pragma unroll
            for (int tn = 0; tn < 4; ++tn)
#pragma unroll
                for (int tm = 0; tm < 2; ++tm)
#pragma unroll
                    for (int g = 0; g < 4; ++g) { u32x2 p; p.x = pk2(acc[tn][tm][4 * g], acc[tn][tm][4 * g + 1]); p.y = pk2(acc[tn][tm][4 * g + 2], acc[tn][tm][4 * g + 3]); put_nat(tn, tm, g, p); }
            flush_nat(isK ? RK : RQ, 512, head * 128);
            if (isK) {
#pragma unroll
                for (int tn = 0; tn < 4; ++tn)
#pragma unroll
                    for (int tm = 0; tm < 2; ++tm)
#pragma unroll
                        for (int g = 0; g < 4; ++g) { u32x2 p; p.x = pk2(acc[tn][tm][4 * g], acc[tn][tm][4 * g + 1]); p.y = pk2(acc[tn][tm][4 * g + 2], acc[tn][tm][4 * g + 3]); put_tr(tn, tm, g, p); }
                flush_tr(RKT, head * 128);
            }
        } else if (nb >= 28) {
            if (nb == 28) {
#pragma unroll
                for (int tm = 0; tm < 2; ++tm) { const int m = m0 + tm * 32 + l31;
#pragma unroll
                    for (int g = 0; g < 4; ++g) { f32x4 v; v.x = acc[0][tm][4 * g]; v.y = acc[0][tm][4 * g + 1]; v.z = acc[0][tm][4 * g + 2]; v.w = acc[0][tm][4 * g + 3];
                        *(f32x4*)(LR + (size_t)m * 32 + 8 * g + 4 * hh) = v; } }
            }
        } else {
            int cls, sub;
            if (nb < 12) { cls = 0; sub = nb - 8; } else if (nb < 16) { cls = 1; sub = nb - 12; } else if (nb < 18) { cls = 2; sub = nb - 16; }
            else if (nb < 20) { cls = 3; sub = nb - 18; } else if (nb < 24) { cls = 4; sub = nb - 20; } else { cls = 5; sub = nb - 24; }
            const bool nat = (cls == 1 || cls == 5) ? lat : (cls == 2 || cls == 3), tr = (cls == 0 || cls == 3 || cls == 4);
            if (nat) {
#pragma unroll
                for (int tn = 0; tn < 4; ++tn)
#pragma unroll
                    for (int tm = 0; tm < 2; ++tm)
#pragma unroll
                        for (int g = 0; g < 4; ++g) { float v[4];
#pragma unroll
                            for (int e = 0; e < 4; ++e) { const float x = acc[tn][tm][4 * g + e]; v[e] = (cls == 1 || cls == 5) ? silu_fast(x) : (cls == 2 ? x * 0.125f : x); }
                            u32x2 p; p.x = pk2(v[0], v[1]); p.y = pk2(v[2], v[3]); put_nat(tn, tm, g, p); }
                flush_nat(cls == 1 ? RG : (cls == 5 ? GG : (cls == 2 ? GQ : GK)), (cls == 2 || cls == 3) ? 256 : 512, sub * 128);
            }
            if (tr) {
#pragma unroll
                for (int tn = 0; tn < 4; ++tn)
#pragma unroll
                    for (int tm = 0; tm < 2; ++tm)
#pragma unroll
                        for (int g = 0; g < 4; ++g) { u32x2 p; p.x = pk2(acc[tn][tm][4 * g], acc[tn][tm][4 * g + 1]); p.y = pk2(acc[tn][tm][4 * g + 2], acc[tn][tm][4 * g + 3]); put_tr(tn, tm, g, p); }
                flush_tr(cls == 0 ? RVT : (cls == 3 ? GKT : GVT), sub * 128);
            }
        }
        __syncthreads();
    }
};
struct EpiOut {
    const float* x; const float* mod; u16* out;
    __device__ __forceinline__ void operator()(f32x16 (&acc)[4][2], int mt, int nt, int wm, int wn, int l31, int hh, unsigned char*, int) const {
#pragma unroll
        for (int tn = 0; tn < 4; ++tn)
#pragma unroll
            for (int tm = 0; tm < 2; ++tm) { const int m = mt * 256 + wm * 64 + tm * 32 + l31; const float* g1 = mod + (m >> 13) * 6144 + 2 * 1024;
#pragma unroll
                for (int g = 0; g < 4; ++g) { const int n = nt * 256 + wn * 128 + tn * 32 + 8 * g + 4 * hh;
                    const f32x4 xv = *(const f32x4*)(x + (size_t)m * D + n), gv = *(const f32x4*)(g1 + n); f32x4 a; a.x = acc[tn][tm][4 * g]; a.y = acc[tn][tm][4 * g + 1]; a.z = acc[tn][tm][4 * g + 2]; a.w = acc[tn][tm][4 * g + 3];
                    const f32x4 o = xv + gv * a; u32x2 p; p.x = pk2(o.x, o.y); p.y = pk2(o.z, o.w); *(u32x2*)(out + (size_t)m * D + n) = p; } }
    }
};
__device__ __forceinline__ unsigned sortable(float x) { const unsigned u = __float_as_uint(x); return (u & 0x80000000u) ? ~u : (u | 0x80000000u); }
__device__ __forceinline__ float unsortable(unsigned s) { const unsigned u = (s & 0x80000000u) ? (s & 0x7fffffffu) : ~s; return __uint_as_float(u); }
#define TOPK_INSERT(t, v) do { unsigned _v = (v); _Pragma("unroll") for (int _s = 0; _s < 16; ++_s) { const unsigned _hi = max((t)[_s], _v); _v = min((t)[_s], _v); (t)[_s] = _hi; } } while (0)
#define CE_DESC(x, y) do { const unsigned hi_ = max((x), (y)), lo_ = min((x), (y)); (x) = hi_; (y) = lo_; } while (0)
__device__ __forceinline__ void bsort16(unsigned (&t)[16]) {
#pragma unroll
    for (int k = 2; k <= 16; k <<= 1)
#pragma unroll
        for (int j = k >> 1; j > 0; j >>= 1)
#pragma unroll
            for (int i = 0; i < 16; ++i) { const int l = i ^ j; if (l > i) { if ((i & k) == 0) CE_DESC(t[i], t[l]); else CE_DESC(t[l], t[i]); } }
}
__device__ __forceinline__ void bmerge16(unsigned (&a)[16], const unsigned (&b)[16]) {
#pragma unroll
    for (int i = 0; i < 16; ++i) a[i] = max(a[i], b[15 - i]);
#pragma unroll
    for (int j = 8; j > 0; j >>= 1)
#pragma unroll
        for (int i = 0; i < 16; ++i) { const int l = i ^ j; if (l > i) CE_DESC(a[i], a[l]); }
}
struct EpiQTopk {
    unsigned char* ws;
    __device__ __forceinline__ void operator()(f32x16 (&acc)[4][2], int mt, int nt, int wm_, int wn_, int l31_, int hh_, unsigned char* lds, int tid_) const {
        const int wm = opaque_i(wm_), wn = opaque_i(wn_), l31 = opaque_i(l31_), hh = opaque_i(hh_), tid = opaque_i(tid_);
        const int head = nt, half = wn;
        { const int lane_ = tid & 63; const u16* KG = (const u16*)(ws + (half ? OFF_K2 : OFF_K1)) + (size_t)head * 128 * 128;
            unsigned char* kl = lds + 65536 + half * 32768 + wm * 8192;
#pragma unroll 1
            for (int i_ = 0; i_ < 8; ++i_) { const int row = wm * 32 + i_ * 4 + (lane_ >> 4), c = (lane_ & 15) ^ (row & 15);
                __builtin_amdgcn_global_load_lds((const unsigned*)(KG + row * 128 + c * 8), (__attribute__((address_space(3))) unsigned*)(kl + i_ * 1024), 16, 0, 0); } }
        const unsigned char* KL = lds + 65536 + half * 32768;
        unsigned* LST = (unsigned*)lds;
        u16* IDX = (u16*)(ws + OFF_IDX); float* GW = (float*)(ws + OFF_GW);
        bf16x8 qf[2][8];
#pragma unroll
        for (int tm = 0; tm < 2; ++tm)
#pragma unroll
            for (int s8 = 0; s8 < 8; ++s8) { const int tn = s8 >> 1, r0 = 8 * (s8 & 1); u32x4 w;
                w.x = pk2(acc[tn][tm][r0 + 0], acc[tn][tm][r0 + 1]); w.y = pk2(acc[tn][tm][r0 + 2], acc[tn][tm][r0 + 3]); w.z = pk2(acc[tn][tm][r0 + 4], acc[tn][tm][r0 + 5]); w.w = pk2(acc[tn][tm][r0 + 6], acc[tn][tm][r0 + 7]);
                qf[tm][s8] = __builtin_bit_cast(bf16x8, w); }
        __builtin_amdgcn_sched_barrier(0);
        asm volatile("s_waitcnt vmcnt(0)" ::: "memory"); __syncthreads();
#pragma unroll
        for (int tm = 0; tm < 2; ++tm) {
            f32x16 sc[4];
#pragma unroll
            for (int kn = 0; kn < 4; ++kn)
#pragma unroll
                for (int r = 0; r < 16; ++r) sc[kn][r] = 0.f;
#pragma unroll
            for (int ks = 0; ks < 8; ++ks)
#pragma unroll
                for (int kn = 0; kn < 4; ++kn) { const bf16x8 a = *(const bf16x8*)(KL + off256(kn * 32 + l31, 2 * ks + hh)); sc[kn] = MFMA(a, qf[tm][ks], sc[kn]); }
            unsigned t[16], t1[16], t2[16], t3[16];
#pragma unroll
            for (int r = 0; r < 16; ++r) { const int nr = acc_row(r, hh);
                t[r] = (sortable(sc[0][r]) & 0xFFFFFF80u) | (unsigned)(127 - nr); t1[r] = (sortable(sc[1][r]) & 0xFFFFFF80u) | (unsigned)(127 - 32 - nr);
                t2[r] = (sortable(sc[2][r]) & 0xFFFFFF80u) | (unsigned)(127 - 64 - nr); t3[r] = (sortable(sc[3][r]) & 0xFFFFFF80u) | (unsigned)(127 - 96 - nr); }
            bsort16(t); bsort16(t1); bsort16(t2); bsort16(t3);
            bmerge16(t, t1); bmerge16(t2, t3); bmerge16(t, t2);
            unsigned pt[16];
#pragma unroll
            for (int s = 0; s < 16; ++s) pt[s] = (unsigned)__shfl_xor((int)t[s], 32);
            bmerge16(t, pt);
            if (hh == 0) {
                u32x4* dst = (u32x4*)(LST + ((wm * 64 + tm * 32 + l31) * 2 + half) * 16);
#pragma unroll
                for (int q = 0; q < 4; ++q) { u32x4 v; v.x = t[4 * q]; v.y = t[4 * q + 1]; v.z = t[4 * q + 2]; v.w = t[4 * q + 3]; dst[q] = v; }
            }
            __builtin_amdgcn_sched_barrier(0);
        }
        __syncthreads();
        if (tid < 256) {
            const int tok = tid; const int mm = mt * 256 + tok;
            unsigned la[16], lb[16];
#pragma unroll
            for (int q = 0; q < 4; ++q) { const u32x4 va = ((const u32x4*)(LST + (tok * 2) * 16))[q], vb = ((const u32x4*)(LST + (tok * 2 + 1) * 16))[q];
                la[4 * q] = va.x; la[4 * q + 1] = va.y; la[4 * q + 2] = va.z; la[4 * q + 3] = va.w; lb[4 * q] = vb.x; lb[4 * q + 1] = vb.y; lb[4 * q + 2] = vb.z; lb[4 * q + 3] = vb.w; }
            float va_[16], vb_[16];
#pragma unroll
            for (int s = 0; s < 16; ++s) { va_[s] = unsortable(la[s] & 0xFFFFFF80u); vb_[s] = unsortable(lb[s] & 0xFFFFFF80u); }
            unsigned t2[16];
#pragma unroll
            for (int s = 0; s < 16; ++s) t2[s] = 0u;
#pragma unroll
            for (int a = 0; a < 16; ++a)
#pragma unroll
                for (int b = 0; b < 16; ++b) if ((a + 1) * (b + 1) <= 16) { const unsigned key = (sortable(va_[a] + vb_[b]) & 0xFFFFFF00u) | (unsigned)(255 - (a * 16 + b)); TOPK_INSERT(t2, key); }
            float ts[16]; const float mx = unsortable(t2[0] & 0xFFFFFF00u); float sum = 0.f;
#pragma unroll
            for (int s = 0; s < 16; ++s) { ts[s] = __expf(unsortable(t2[s] & 0xFFFFFF00u) - mx); sum += ts[s]; }
            const float inv = 1.f / sum;
            int io[16];
#pragma unroll
            for (int s = 0; s < 16; ++s) { const int ab = 255 - (int)(t2[s] & 255u); const int a = ab >> 4, b = ab & 15;
                const int i1 = 127 - (int)(LST[(tok * 2) * 16 + a] & 127u), i2 = 127 - (int)(LST[(tok * 2 + 1) * 16 + b] & 127u); io[s] = i1 * 128 + i2; ts[s] *= inv; }
            u32x4* ip = (u32x4*)(IDX + (size_t)mm * 128 + head * 16); f32x4* gp = (f32x4*)(GW + (size_t)mm * 128 + head * 16);
#pragma unroll
            for (int q = 0; q < 2; ++q) { u32x4 v; v.x = (unsigned)io[8 * q] | ((unsigned)io[8 * q + 1] << 16); v.y = (unsigned)io[8 * q + 2] | ((unsigned)io[8 * q + 3] << 16); v.z = (unsigned)io[8 * q + 4] | ((unsigned)io[8 * q + 5] << 16); v.w = (unsigned)io[8 * q + 6] | ((unsigned)io[8 * q + 7] << 16); ip[q] = v; }
#pragma unroll
            for (int q = 0; q < 4; ++q) { f32x4 g; g.x = ts[4 * q]; g.y = ts[4 * q + 1]; g.z = ts[4 * q + 2]; g.w = ts[4 * q + 3]; gp[q] = g; }
        }
        __syncthreads();
    }
};

struct HookNone { __device__ __forceinline__ void issue(int, int) {} __device__ __forceinline__ void finish(int, int) {} };
struct HookDown {
    const float* src; unsigned char* dst; float* dsc; int gw, NGW, ln; f32x4 v[2][4];
    __device__ __forceinline__ void issue(int t, int nch) { const int per = 8 / nch;
#pragma unroll
        for (int u = 0; u < 2; ++u) if (u < per) { const float* p = src + (size_t)(gw + NGW * (t * per + u)) * 1024 + ln * 16;
#pragma unroll
            for (int q = 0; q < 4; ++q) v[u][q] = *(const f32x4*)(p + 4 * q); } }
    __device__ __forceinline__ void finish(int t, int nch) { const int per = 8 / nch;
#pragma unroll
        for (int u = 0; u < 2; ++u) if (u < per) { const int e = gw + NGW * (t * per + u); float mx = 0.f;
#pragma unroll
            for (int q = 0; q < 4; ++q) mx = fmaxf(mx, fmaxf(fmaxf(fabsf(v[u][q].x), fabsf(v[u][q].y)), fmaxf(fabsf(v[u][q].z), fabsf(v[u][q].w))));
            mx = fmaxf(wave_max(mx), 1e-30f); const float qsc = 127.f / mx; u32x4 o;
            o.x = q8x4(v[u][0].x, v[u][0].y, v[u][0].z, v[u][0].w, qsc); o.y = q8x4(v[u][1].x, v[u][1].y, v[u][1].z, v[u][1].w, qsc); o.z = q8x4(v[u][2].x, v[u][2].y, v[u][2].z, v[u][2].w, qsc); o.w = q8x4(v[u][3].x, v[u][3].y, v[u][3].z, v[u][3].w, qsc);
            *(u32x4*)(dst + (size_t)(ln >> 3) * 2097152 + (size_t)e * 128 + (size_t)(ln & 7) * 16) = o;
            if (ln == 0) dsc[e] = mx * (1.f / 127.f); } }
};
struct HookUp {
    const float* src; unsigned char* dst; int gt, NGT; f32x4 a[2][4];
    __device__ __forceinline__ void issue(int t, int nch) { const int per = 8 / nch;
#pragma unroll
        for (int u = 0; u < 2; ++u) if (u < per) { const float* p = src + (size_t)(gt + NGT * (t * per + u)) * 16;
#pragma unroll
            for (int q = 0; q < 4; ++q) a[u][q] = *(const f32x4*)(p + 4 * q); } }
    __device__ __forceinline__ void finish(int t, int nch) { const int per = 8 / nch;
#pragma unroll
        for (int u = 0; u < 2; ++u) if (u < per) { const int ch = gt + NGT * (t * per + u); u32x4 o; unsigned ow[4];
#pragma unroll
            for (int q = 0; q < 4; ++q) { int p = 0; p = __builtin_amdgcn_cvt_pk_fp8_f32(a[u][q].x * UP_SCALE, a[u][q].y * UP_SCALE, p, false); p = __builtin_amdgcn_cvt_pk_fp8_f32(a[u][q].z * UP_SCALE, a[u][q].w * UP_SCALE, p, true); ow[q] = (unsigned)p; }
            o.x = ow[0]; o.y = ow[1]; o.z = ow[2]; o.w = ow[3];
            *(u32x4*)(dst + (size_t)((ch & 63) >> 3) * 2097152 + (size_t)(ch >> 6) * 128 + (size_t)(ch & 7) * 16) = o; } }
};
constexpr int RS_Q = 0, RS_K = 16384, RS_KT = 32768, RS_VT = 49152, RS_P = 65536, RS_ST = 73728;
constexpr int GS_Q = 0, GS_K = 8192, GS_KT = 16384, GS_VT = 24576, GS_P = 40960, GS_ST = 49152, GS_LR = 65536, GS_SEG = 69632, GS_GL = 71680, GS_G = 71936;

template <int MODE, class Hook>
__device__ __forceinline__ void scan_ret2(const Args& A, unsigned char* lds, int gr, int k, int tid, Hook& hook) {
    const int lane = tid & 63, wave = tid >> 6, l31 = lane & 31, hh = lane >> 5;
    const int b = gr >> 3, h = (gr >> 1) & 3, dir = gr & 1;
    const u16* RQ = (const u16*)(A.ws + OFF_RQ); const u16* RK = (const u16*)(A.ws + OFF_RK); const u16* RKT = (const u16*)(A.ws + OFF_RKT); const u16* RVT = (const u16*)(A.ws + OFF_RVT);
    u16* OUT = (u16*)(A.ws + (dir ? OFF_ORB : OFF_ORF));
    const float lg = logsig_f(A.in[dir ? 10 : 9][h]); const float lg2c = lg * 1.4426950408889634f; float lg2 = lg2c;
    const float cd = __builtin_amdgcn_exp2f(lg2c * 64.f);
    const int nch = (k == 0) ? 4 : 8;
    const int dt = wave >> 1, wt0 = (wave & 1) * 2;
    f32x16 S[2];
    if (MODE == 1) {
        const float* slot = (const float*)(A.ws + OFF_SLOT_R) + (size_t)(gr * 16 + k - 1) * 16384;
#pragma unroll
        for (int q = 0; q < 2; ++q)
#pragma unroll
            for (int r = 0; r < 16; ++r) S[q][r] = slot[(dt * 32 + acc_row(r, hh)) * 128 + (wt0 + q) * 32 + l31];
    } else {
#pragma unroll
        for (int q = 0; q < 2; ++q)
#pragma unroll
            for (int r = 0; r < 16; ++r) S[q][r] = 0.f;
    }
    u32x4 rq[2], rk[2], rkt[2], rvt[2];
    auto tok0_of = [&](int t) -> int { if (k == 0) { const int cc = dir ? 3 - t : t; return T_LAT + b * CTXL + cc * 64; } const int sc = dir ? 16 - k : k - 1; const int c = sc * 8 + (dir ? 7 - t : t); return b * SEQ + c * 64; };
    auto issue = [&](int t) {
        const int tok0 = tok0_of(t);
#pragma unroll
        for (int e = 0; e < 2; ++e) { const int idx = tid + 512 * e;
            if (MODE == 1) { const int row = idx >> 4, ch = idx & 15; rq[e] = *(const u32x4*)(RQ + (size_t)(tok0 + row) * 512 + h * 128 + ch * 8); rk[e] = *(const u32x4*)(RK + (size_t)(tok0 + row) * 512 + h * 128 + ch * 8); }
            const int rowt = idx >> 3, cht = idx & 7; rkt[e] = *(const u32x4*)(RKT + (size_t)(h * 128 + rowt) * T_ALL + tok0 + cht * 8); rvt[e] = *(const u32x4*)(RVT + (size_t)(h * 128 + rowt) * T_ALL + tok0 + cht * 8); }
    };
    auto stage = [&]() {
#pragma unroll
        for (int e = 0; e < 2; ++e) { const int idx = tid + 512 * e;
            if (MODE == 1) { const int row = idx >> 4, ch = idx & 15; *(u32x4*)(lds + RS_Q + off256(row, ch)) = rq[e]; *(u32x4*)(lds + RS_K + off256(row, ch)) = rk[e]; }
            const int rowt = idx >> 3, cht = idx & 7; u32x4 v = rkt[e]; unsigned w[4] = {v.x, v.y, v.z, v.w};
#pragma unroll
            for (int q = 0; q < 4; ++q) { const int j = cht * 8 + 2 * q; const float e0 = dir ? (float)j : (float)(63 - j), e1 = dir ? (float)(j + 1) : (float)(62 - j);
                w[q] = pk2(bf_lo(w[q]) * __builtin_amdgcn_exp2f(lg2 * e0), bf_hi(w[q]) * __builtin_amdgcn_exp2f(lg2 * e1)); }
            v.x = w[0]; v.y = w[1]; v.z = w[2]; v.w = w[3];
            *(u32x4*)(lds + RS_KT + off128(rowt, cht)) = v; *(u32x4*)(lds + RS_VT + off128(rowt, cht)) = rvt[e]; }
    };
    auto put_st = [&]() {
#pragma unroll
        for (int q = 0; q < 2; ++q)
#pragma unroll
            for (int g = 0; g < 4; ++g) { u32x2 p; p.x = pk2(S[q][4 * g], S[q][4 * g + 1]); p.y = pk2(S[q][4 * g + 2], S[q][4 * g + 3]);
                *(u32x2*)(lds + RS_ST + off256((wt0 + q) * 32 + l31, dt * 4 + g) + hh * 8) = p; }
    };
    auto do_u = [&]() {
#pragma unroll
        for (int q = 0; q < 2; ++q)
#pragma unroll
            for (int r = 0; r < 16; ++r) S[q][r] *= cd;
#pragma unroll
        for (int ks = 0; ks < 4; ++ks) { const bf16x8 a = *(const bf16x8*)(lds + RS_KT + off128(dt * 32 + l31, 2 * ks + hh));
#pragma unroll
            for (int q = 0; q < 2; ++q) { const bf16x8 bv = *(const bf16x8*)(lds + RS_VT + off128((wt0 + q) * 32 + l31, 2 * ks + hh)); S[q] = MFMA(a, bv, S[q]); } }
    };
    issue(0);
    if (MODE == 1) put_st();
    for (int t = 0; t < nch; ++t) {
        const int tok0 = tok0_of(t);
        asm volatile("" : "+v"(lg2));
        stage();
        __syncthreads();
        if (t + 1 < nch) issue(t + 1);
        if (MODE == 0) { hook.issue(t, nch); do_u(); hook.finish(t, nch); __syncthreads(); continue; }
        if (wave < 4) {
            const int tj = wave >> 1, ti = wave & 1; f32x16 P;
#pragma unroll
            for (int r = 0; r < 16; ++r) P[r] = 0.f;
#pragma unroll
            for (int ks = 0; ks < 8; ++ks) { const bf16x8 a = *(const bf16x8*)(lds + RS_K + off256(tj * 32 + l31, 2 * ks + hh)); const bf16x8 bq = *(const bf16x8*)(lds + RS_Q + off256(ti * 32 + l31, 2 * ks + hh)); P = MFMA(a, bq, P); }
            const int i = ti * 32 + l31;
#pragma unroll
            for (int g = 0; g < 4; ++g) { float v[4];
#pragma unroll
                for (int e = 0; e < 4; ++e) { const int j = tj * 32 + 8 * g + 4 * hh + e; const int dlt = dir ? (j - i) : (i - j); v[e] = dlt >= 0 ? P[4 * g + e] * __builtin_amdgcn_exp2f(lg2 * (float)dlt) : 0.f; }
                u32x2 p; p.x = pk2(v[0], v[1]); p.y = pk2(v[2], v[3]);
                *(u32x2*)(lds + RS_P + off128(i, tj * 4 + g) + hh * 8) = p; }
        } else do_u();
        __syncthreads();
        {
            const int wt = wave >> 1, ti = wave & 1; f32x16 O;
#pragma unroll
            for (int r = 0; r < 16; ++r) O[r] = 0.f;
#pragma unroll
            for (int ks = 0; ks < 8; ++ks) { const bf16x8 a = *(const bf16x8*)(lds + RS_ST + off256(wt * 32 + l31, 2 * ks + hh)); const bf16x8 bq = *(const bf16x8*)(lds + RS_Q + off256(ti * 32 + l31, 2 * ks + hh)); O = MFMA(a, bq, O); }
            const int i = ti * 32 + l31; const float qd = __builtin_amdgcn_exp2f(lg2 * (dir ? (float)(64 - i) : (float)(i + 1)));
#pragma unroll
            for (int r = 0; r < 16; ++r) O[r] *= qd;
#pragma unroll
            for (int ks = 0; ks < 4; ++ks) { const bf16x8 a = *(const bf16x8*)(lds + RS_VT + off128(wt * 32 + l31, 2 * ks + hh)); const bf16x8 bp = *(const bf16x8*)(lds + RS_P + off128(ti * 32 + l31, 2 * ks + hh)); O = MFMA(a, bp, O); }
            u16* op = OUT + (size_t)(tok0 + i) * 512 + h * 128 + wt * 32;
#pragma unroll
            for (int g = 0; g < 4; ++g) { u32x2 p; p.x = pk2(O[4 * g], O[4 * g + 1]); p.y = pk2(O[4 * g + 2], O[4 * g + 3]); *(u32x2*)(op + 8 * g + 4 * hh) = p; }
        }
        if (wave < 4) do_u();
        __syncthreads();
        if (t + 1 < nch) put_st();
    }
    if (MODE == 0) {
        float* slot = (float*)(A.ws + OFF_SLOT_R) + (size_t)(gr * 16 + k) * 16384;
#pragma unroll
        for (int q = 0; q < 2; ++q)
#pragma unroll
            for (int r = 0; r < 16; ++r) slot[(dt * 32 + acc_row(r, hh)) * 128 + (wt0 + q) * 32 + l31] = S[q][r];
    }
}

template <int MODE, class Hook>
__device__ __forceinline__ void scan_gla2(const Args& A, unsigned char* lds, int gr, int k, int tid, Hook& hook) {
    const int lane = tid & 63, wave = tid >> 6, l31 = lane & 31, hh = lane >> 5;
    const int b = gr >> 3, h = (gr >> 1) & 3, dir = gr & 1;
    const u16* GQ = (const u16*)(A.ws + OFF_GQ); const u16* GK = (const u16*)(A.ws + OFF_GK); const u16* GKT = (const u16*)(A.ws + OFF_GKT); const u16* GVT = (const u16*)(A.ws + OFF_GVT);
    const float* LR = (const float*)(A.ws + OFF_LR);
    u16* OUT = (u16*)(A.ws + (dir ? OFF_OGB : OFF_OGF));
    const float* up = A.in[dir ? 13 : 11]; const float* bias = A.in[dir ? 14 : 12];
    const int dmy = tid & 63, seg = tid >> 6;
    float upr[16];
#pragma unroll
    for (int r = 0; r < 16; ++r) upr[r] = up[r * 256 + h * 64 + dmy];
    const float bs = bias[h * 64 + dmy];
    const int nch = (k == 0) ? 4 : 8;
    const int dt = wave >> 2, wt = wave & 3;
    f32x16 S;
    if (MODE == 1) {
        const float* slot = (const float*)(A.ws + OFF_SLOT_G) + (size_t)(gr * 16 + k - 1) * 8192;
#pragma unroll
        for (int r = 0; r < 16; ++r) S[r] = slot[(dt * 32 + acc_row(r, hh)) * 128 + wt * 32 + l31];
    } else {
#pragma unroll
        for (int r = 0; r < 16; ++r) S[r] = 0.f;
    }
    float gsum = 0.f;
    u32x4 rq, rk, rkt, rvt[2]; f32x4 rlr;
    auto tok0_of = [&](int t) -> int { if (k == 0) { const int cc = dir ? 3 - t : t; return T_LAT + b * CTXL + cc * 64; } const int sc = dir ? 16 - k : k - 1; const int c = sc * 8 + (dir ? 7 - t : t); return b * SEQ + c * 64; };
    auto issue = [&](int t) {
        const int tok0 = tok0_of(t); const int row = tid >> 3, ch = tid & 7;
        if (MODE == 1) { rq = *(const u32x4*)(GQ + (size_t)(tok0 + row) * 256 + h * 64 + ch * 8); rk = *(const u32x4*)(GK + (size_t)(tok0 + row) * 256 + h * 64 + ch * 8); }
        rkt = *(const u32x4*)(GKT + (size_t)(h * 64 + row) * T_ALL + tok0 + ch * 8);
#pragma unroll
        for (int e = 0; e < 2; ++e) rvt[e] = *(const u32x4*)(GVT + (size_t)(h * 128 + e * 64 + row) * T_ALL + tok0 + ch * 8);
        if (tid < 256) rlr = *(const f32x4*)(LR + (size_t)(tok0 + (tid >> 2)) * 32 + dir * 16 + (tid & 3) * 4);
    };
    auto put_st = [&]() {
#pragma unroll
        for (int g = 0; g < 4; ++g) { u32x2 p; p.x = pk2(S[4 * g], S[4 * g + 1]); p.y = pk2(S[4 * g + 2], S[4 * g + 3]);
            *(u32x2*)(lds + GS_ST + off128(wt * 32 + l31, dt * 4 + g) + hh * 8) = p; }
    };
    float* LRs = (float*)(lds + GS_LR); float* SEGs = (float*)(lds + GS_SEG); float* GLs = (float*)(lds + GS_GL); float* Gs = (float*)(lds + GS_G);
    auto do_u = [&]() {
#pragma unroll
        for (int r = 0; r < 16; ++r) S[r] *= __expf(GLs[dt * 32 + acc_row(r, hh)]);
#pragma unroll
        for (int ks = 0; ks < 4; ++ks) { const bf16x8 a = *(const bf16x8*)(lds + GS_KT + off128(dt * 32 + l31, 2 * ks + hh)); const bf16x8 bv = *(const bf16x8*)(lds + GS_VT + off128(wt * 32 + l31, 2 * ks + hh)); S = MFMA(a, bv, S); }
    };
    issue(0);
    if (MODE == 1) put_st();
    for (int t = 0; t < nch; ++t) {
        const int tok0 = tok0_of(t);
        if (tid < 256) *(f32x4*)(LRs + (tid >> 2) * 16 + (tid & 3) * 4) = rlr;
        __syncthreads();
        float pre[8];
#pragma unroll
        for (int e = 0; e < 8; ++e) { const float* lr = LRs + (seg * 8 + e) * 16; float a = bs;
#pragma unroll
            for (int r = 0; r < 16; ++r) a += lr[r] * upr[r];
            pre[e] = logsig_fast(a) * 0.0625f; }
        if (!dir) {
#pragma unroll
            for (int e = 1; e < 8; ++e) pre[e] += pre[e - 1];
            SEGs[seg * 64 + dmy] = pre[7];
        } else {
#pragma unroll
            for (int e = 6; e >= 0; --e) pre[e] += pre[e + 1];
            SEGs[seg * 64 + dmy] = pre[0];
        }
        __syncthreads();
        { float off = 0.f, tot = 0.f;
#pragma unroll
            for (int q = 0; q < 8; ++q) { const float v = SEGs[q * 64 + dmy]; tot += v; if (dir ? (q > seg) : (q < seg)) off += v; }
#pragma unroll
            for (int e = 0; e < 8; ++e) Gs[(seg * 8 + e) * 65 + dmy] = off + pre[e];
            if (seg == 0) { GLs[dmy] = tot; gsum += tot; } }
        __syncthreads();
        { const int row = tid >> 3, ch = tid & 7;
            if (MODE == 1) { unsigned w[4] = {rq.x, rq.y, rq.z, rq.w}; const float* g = Gs + row * 65 + ch * 8;
#pragma unroll
                for (int q = 0; q < 4; ++q) w[q] = pk2(bf_lo(w[q]) * __expf(g[2 * q]), bf_hi(w[q]) * __expf(g[2 * q + 1]));
                u32x4 v; v.x = w[0]; v.y = w[1]; v.z = w[2]; v.w = w[3]; *(u32x4*)(lds + GS_Q + off128(row, ch)) = v;
                unsigned wk[4] = {rk.x, rk.y, rk.z, rk.w};
#pragma unroll
                for (int q = 0; q < 4; ++q) wk[q] = pk2(bf_lo(wk[q]) * __expf(-g[2 * q]), bf_hi(wk[q]) * __expf(-g[2 * q + 1]));
                v.x = wk[0]; v.y = wk[1]; v.z = wk[2]; v.w = wk[3]; *(u32x4*)(lds + GS_K + off128(row, ch)) = v; }
            { unsigned w[4] = {rkt.x, rkt.y, rkt.z, rkt.w}; const float gl = GLs[row];
#pragma unroll
                for (int q = 0; q < 4; ++q) { const int j = ch * 8 + 2 * q; w[q] = pk2(bf_lo(w[q]) * __expf(gl - Gs[j * 65 + row]), bf_hi(w[q]) * __expf(gl - Gs[(j + 1) * 65 + row])); }
                u32x4 v; v.x = w[0]; v.y = w[1]; v.z = w[2]; v.w = w[3]; *(u32x4*)(lds + GS_KT + off128(row, ch)) = v; }
#pragma unroll
            for (int e = 0; e < 2; ++e) *(u32x4*)(lds + GS_VT + off128(e * 64 + row, ch)) = rvt[e];
        }
        __syncthreads();
        if (t + 1 < nch) issue(t + 1);
        if (MODE == 0) { hook.issue(t, nch); do_u(); hook.finish(t, nch); __syncthreads(); continue; }
        if (wave < 4) {
            const int tj = wave >> 1, ti = wave & 1; f32x16 P;
#pragma unroll
            for (int r = 0; r < 16; ++r) P[r] = 0.f;
#pragma unroll
            for (int ks = 0; ks < 4; ++ks) { const bf16x8 a = *(const bf16x8*)(lds + GS_K + off128(tj * 32 + l31, 2 * ks + hh)); const bf16x8 bq = *(const bf16x8*)(lds + GS_Q + off128(ti * 32 + l31, 2 * ks + hh)); P = MFMA(a, bq, P); }
            const int i = ti * 32 + l31;
#pragma unroll
            for (int g = 0; g < 4; ++g) { float v[4];
#pragma unroll
                for (int e = 0; e < 4; ++e) { const int j = tj * 32 + 8 * g + 4 * hh + e; const bool keep = dir ? (j >= i) : (i >= j); v[e] = keep ? P[4 * g + e] : 0.f; }
                u32x2 p; p.x = pk2(v[0], v[1]); p.y = pk2(v[2], v[3]);
                *(u32x2*)(lds + GS_P + off128(i, tj * 4 + g) + hh * 8) = p; }
        } else do_u();
        __syncthreads();
        {
            const int ot = wave >> 1, ti = wave & 1; f32x16 O;
#pragma unroll
            for (int r = 0; r < 16; ++r) O[r] = 0.f;
#pragma unroll
            for (int ks = 0; ks < 4; ++ks) { const bf16x8 a = *(const bf16x8*)(lds + GS_ST + off128(ot * 32 + l31, 2 * ks + hh)); const bf16x8 bq = *(const bf16x8*)(lds + GS_Q + off128(ti * 32 + l31, 2 * ks + hh)); O = MFMA(a, bq, O); }
#pragma unroll
            for (int ks = 0; ks < 4; ++ks) { const bf16x8 a = *(const bf16x8*)(lds + GS_VT + off128(ot * 32 + l31, 2 * ks + hh)); const bf16x8 bp = *(const bf16x8*)(lds + GS_P + off128(ti * 32 + l31, 2 * ks + hh)); O = MFMA(a, bp, O); }
            const int i = ti * 32 + l31;
            u16* op = OUT + (size_t)(tok0 + i) * 512 + h * 128 + ot * 32;
#pragma unroll
            for (int g = 0; g < 4; ++g) { u32x2 p; p.x = pk2(O[4 * g], O[4 * g + 1]); p.y = pk2(O[4 * g + 2], O[4 * g + 3]); *(u32x2*)(op + 8 * g + 4 * hh) = p; }
        }
        if (wave < 4) do_u();
        __syncthreads();
        if (t + 1 < nch) put_st();
    }
    if (MODE == 0) {
        float* slot = (float*)(A.ws + OFF_SLOT_G) + (size_t)(gr * 16 + k) * 8192;
#pragma unroll
        for (int r = 0; r < 16; ++r) slot[(dt * 32 + acc_row(r, hh)) * 128 + wt * 32 + l31] = S[r];
        if (tid < 64) ((float*)(A.ws + OFF_GSUM))[(gr * 16 + k) * 64 + tid] = gsum;
    }
}

__device__ __forceinline__ void scan_combine(const Args& A, int bid, int G, int tid) {
    const int gt = bid * NTHREADS + tid, NGT = G * NTHREADS;
    for (int i = gt; i < 16 * 4096 + 16 * 2048; i += NGT) {
        if (i < 16 * 4096) { const int gr = i >> 12, e4 = i & 4095; const int h = (gr >> 1) & 3, dir = gr & 1;
            const float dec = exp2f(logsig_f(A.in[dir ? 10 : 9][h]) * 1.4426950408889634f * 512.f);
            f32x4* base = (f32x4*)(A.ws + OFF_SLOT_R) + (size_t)gr * 16 * 4096 + e4; f32x4 run = base[0];
            for (int k = 2; k <= 16; ++k) { f32x4 v = base[(size_t)(k - 1) * 4096]; run = run * dec + v; base[(size_t)(k - 1) * 4096] = run; }
        } else { const int ii = i - 16 * 4096; const int gr = ii >> 11, e4 = ii & 2047; const int d = e4 >> 5;
            const float* gs = (const float*)(A.ws + OFF_GSUM) + gr * 16 * 64 + d;
            f32x4* base = (f32x4*)(A.ws + OFF_SLOT_G) + (size_t)gr * 16 * 2048 + e4; f32x4 run = base[0];
            for (int k = 2; k <= 16; ++k) { const float dec = __expf(gs[(k - 1) * 64]); f32x4 v = base[(size_t)(k - 1) * 2048]; run = run * dec + v; base[(size_t)(k - 1) * 2048] = run; }
        }
    }
}


__device__ __forceinline__ void phase4(const Args& A, int gw, int NGW, int lane) {
    u16* Y = (u16*)(A.ws + OFF_Y);
    const int niter_ = (NGW == 2048) ? 8 : (T_LAT + NGW - 1) / NGW;
    for (int i_ = 0; i_ < niter_; ++i_) { const int tok = xcd_row(i_, gw, NGW); if (tok >= T_LAT) break;
#pragma unroll
        for (int part = 0; part < 2; ++part) {
            const u16* OF = (const u16*)(A.ws + (part ? OFF_OGF : OFF_ORF)); const u16* OB = (const u16*)(A.ws + (part ? OFF_OGB : OFF_ORB)); const u16* GT = (const u16*)(A.ws + (part ? OFF_GG : OFF_RG));
            const u32x4 a = *(const u32x4*)(OF + (size_t)tok * 512 + lane * 8), b = *(const u32x4*)(OB + (size_t)tok * 512 + lane * 8), g = *(const u32x4*)(GT + (size_t)tok * 512 + lane * 8);
            const unsigned aw[4] = {a.x, a.y, a.z, a.w}, bw[4] = {b.x, b.y, b.z, b.w}, gw4[4] = {g.x, g.y, g.z, g.w};
            float o[8]; float ss = 0.f;
#pragma unroll
            for (int q = 0; q < 4; ++q) { o[2 * q] = bf_lo(aw[q]) + bf_lo(bw[q]); o[2 * q + 1] = bf_hi(aw[q]) + bf_hi(bw[q]); ss += o[2 * q] * o[2 * q] + o[2 * q + 1] * o[2 * q + 1]; }
            ss += __shfl_xor(ss, 1); ss += __shfl_xor(ss, 2); ss += __shfl_xor(ss, 4); ss += __shfl_xor(ss, 8);
            const float rs = 1.f / sqrtf(ss * (1.f / 128.f) + 1e-6f);
            u32x4 y; unsigned yw[4];
#pragma unroll
            for (int q = 0; q < 4; ++q) yw[q] = pk2(o[2 * q] * rs * bf_lo(gw4[q]), o[2 * q + 1] * rs * bf_hi(gw4[q]));
            y.x = yw[0]; y.y = yw[1]; y.z = yw[2]; y.w = yw[3];
            *(u32x4*)(Y + (size_t)tok * PITCH + part * 512 + lane * 8) = y;
        }
    }
}

__device__ __forceinline__ float dpp_sum8(float v) {
    v += __builtin_bit_cast(float, __builtin_amdgcn_update_dpp(0, __builtin_bit_cast(int, v), 0xB1, 0xF, 0xF, true));
    v += __builtin_bit_cast(float, __builtin_amdgcn_update_dpp(0, __builtin_bit_cast(int, v), 0x4E, 0xF, 0xF, true));
    v += __builtin_bit_cast(float, __builtin_amdgcn_update_dpp(0, __builtin_bit_cast(int, v), 0x141, 0xF, 0xF, true));
    return v;
}
__device__ __forceinline__ int dpp_isum8(int v) {
    v += __builtin_amdgcn_update_dpp(0, v, 0xB1, 0xF, 0xF, true);
    v += __builtin_amdgcn_update_dpp(0, v, 0x4E, 0xF, 0xF, true);
    v += __builtin_amdgcn_update_dpp(0, v, 0x141, 0xF, 0xF, true);
    return v;
}
__device__ __forceinline__ void gather_down(const Args& A, int bid, int G, int wave, int lane) {
    const unsigned char* H2Q = A.ws + OFF_H2Q; const u16* IDX = (const u16*)(A.ws + OFF_IDX);
    const int x = bid & 7, nwx = (G >> 3) * NWAVES, wv = (bid >> 3) * NWAVES + wave;
    const unsigned char* DNS = (const unsigned char*)A.out + DOUT_DOWN + (size_t)x * 2097152 + (lane & 7) * 16;
    u16* PART = (u16*)(A.ws + OFF_PART) + (size_t)x * T_LAT * 128;
    const int r = lane >> 3;
    constexpr int U = 2;
    u32x4 ei[U][2], hq[U];
#pragma unroll
    for (int u = 0; u < U; ++u) { const int t0 = wv + u * nwx; const u32x4* ip0 = (const u32x4*)(IDX + (size_t)t0 * 128 + r * 16); ei[u][0] = ip0[0]; ei[u][1] = ip0[1];
        hq[u] = *(const u32x4*)(H2Q + (size_t)t0 * 1024 + x * 128 + (lane & 7) * 16); }
    for (int tok = wv; tok < T_LAT; tok += U * nwx) {
        u32x4 rows[U][16]; u32x4 hr[U];
#pragma unroll
        for (int u = 0; u < U; ++u) { const unsigned ew[8] = {ei[u][0].x, ei[u][0].y, ei[u][0].z, ei[u][0].w, ei[u][1].x, ei[u][1].y, ei[u][1].z, ei[u][1].w};
#pragma unroll
            for (int it = 0; it < 16; ++it) { const unsigned e = (it & 1) ? (ew[it >> 1] >> 16) : (ew[it >> 1] & 0xffffu); rows[u][it] = *(const u32x4*)(DNS + (size_t)e * 128); }
            hr[u] = hq[u]; }
#pragma unroll
        for (int u = 0; u < U; ++u) { const int tn = tok + (U + u) * nwx < T_LAT ? tok + (U + u) * nwx : tok; const u32x4* ipn = (const u32x4*)(IDX + (size_t)tn * 128 + r * 16); ei[u][0] = ipn[0]; ei[u][1] = ipn[1];
            hq[u] = *(const u32x4*)(H2Q + (size_t)tn * 1024 + x * 128 + (lane & 7) * 16); }
#pragma unroll
        for (int u = 0; u < U; ++u) { int res[16];
#pragma unroll
            for (int it = 0; it < 16; ++it) { int a = 0;
                a = __builtin_amdgcn_sdot4((int)rows[u][it].x, (int)hr[u].x, a, false); a = __builtin_amdgcn_sdot4((int)rows[u][it].y, (int)hr[u].y, a, false);
                a = __builtin_amdgcn_sdot4((int)rows[u][it].z, (int)hr[u].z, a, false); a = __builtin_amdgcn_sdot4((int)rows[u][it].w, (int)hr[u].w, a, false);
                res[it] = dpp_isum8(a); }
            if ((lane & 7) == 0) { u32x4* pp = (u32x4*)(PART + (size_t)(tok + u * nwx) * 128 + r * 16);
#pragma unroll
                for (int q = 0; q < 2; ++q) { u32x4 v; v.x = pkh2((float)res[8 * q] * 0.015625f, (float)res[8 * q + 1] * 0.015625f); v.y = pkh2((float)res[8 * q + 2] * 0.015625f, (float)res[8 * q + 3] * 0.015625f);
                    v.z = pkh2((float)res[8 * q + 4] * 0.015625f, (float)res[8 * q + 5] * 0.015625f); v.w = pkh2((float)res[8 * q + 6] * 0.015625f, (float)res[8 * q + 7] * 0.015625f); pp[q] = v; } } }
    }
}
__device__ __forceinline__ void gather_coef(const Args& A, int bid, int G, int tid) {
    const u16* PART = (const u16*)(A.ws + OFF_PART); const float* GWt = (const float*)(A.ws + OFF_GW); u16* COEF = (u16*)(A.ws + OFF_COEF);
    const u16* IDX = (const u16*)(A.ws + OFF_IDX); const float* HS = (const float*)(A.ws + OFF_HS); const float* DSC = (const float*)((const unsigned char*)A.out + DOUT_DSC);
    typedef int i32x4 __attribute__((ext_vector_type(4)));
    const int gt = bid * NTHREADS + tid, NGT = G * NTHREADS;
    for (int i = gt; i < T_LAT * 32; i += NGT) {
        f32x4 s = {0.f, 0.f, 0.f, 0.f}; u32x2 pv[8];
#pragma unroll
        for (int xs = 0; xs < 8; ++xs) pv[xs] = *(const u32x2*)(PART + (size_t)xs * T_LAT * 128 + (size_t)i * 4);
#pragma unroll
        for (int xs = 0; xs < 8; ++xs) { const f32x2 lo = unpkh2(pv[xs].x), hi = unpkh2(pv[xs].y); s.x += lo.x; s.y += lo.y; s.z += hi.x; s.w += hi.y; }
        s = s * 64.f;
        const f32x4 g = *(const f32x4*)(GWt + (size_t)i * 4); const u32x2 ew = *(const u32x2*)(IDX + (size_t)i * 4); const float hs = HS[i >> 5]; f32x4 o;
        { const float v = s.x * hs * DSC[ew.x & 0xffffu]; o.x = 0.5f * v * (1.f + erff(v * 0.70710678118654752f)) * g.x * (1.f / UP_SCALE); }
        { const float v = s.y * hs * DSC[ew.x >> 16];     o.y = 0.5f * v * (1.f + erff(v * 0.70710678118654752f)) * g.y * (1.f / UP_SCALE); }
        { const float v = s.z * hs * DSC[ew.y & 0xffffu]; o.z = 0.5f * v * (1.f + erff(v * 0.70710678118654752f)) * g.z * (1.f / UP_SCALE); }
        { const float v = s.w * hs * DSC[ew.y >> 16];     o.w = 0.5f * v * (1.f + erff(v * 0.70710678118654752f)) * g.w * (1.f / UP_SCALE); }
        u32x2 p; p.x = pk2(o.x, o.y); p.y = pk2(o.z, o.w); *(u32x2*)(COEF + (size_t)i * 4) = p;
    }
}
__device__ __forceinline__ void gather_up(const Args& A, int bid, int G, int wave, int lane) {
    const u16* IDX = (const u16*)(A.ws + OFF_IDX); const u16* COEF = (const u16*)(A.ws + OFF_COEF); float* SSQ = (float*)(A.ws + OFF_SSQ);
    const float* mod = (const float*)(A.ws + OFF_MOD); u16* out = (u16*)(A.ws + OFF_X1);
    const int x = bid & 7, nwx = (G >> 3) * NWAVES, wv = (bid >> 3) * NWAVES + wave;
    const unsigned char* UPS = (const unsigned char*)A.out + DOUT_UP + (size_t)x * 2097152 + (lane & 7) * 16;
    const int r = lane >> 3, col = x * 128 + (lane & 7) * 16 + 2 * r;
    const int nu = T_LAT / nwx;
    struct RS { u32x4 rows[16]; u32x4 cw[2]; f32x2 gv; unsigned x1v; };
    RS SA, SB; u32x4 eiA[2], eiB[2];
    auto ld_idx = [&](int n, u32x4 (&ei)[2]) { const int t = wv + (n < nu ? n : nu - 1) * nwx; const u32x4* ip = (const u32x4*)(IDX + (size_t)t * 128 + r * 16); ei[0] = ip[0]; ei[1] = ip[1]; };
    auto ld_rows = [&](int n, const u32x4 (&ei)[2], RS& rs) { const int t = wv + (n < nu ? n : nu - 1) * nwx;
        const unsigned ew[8] = {ei[0].x, ei[0].y, ei[0].z, ei[0].w, ei[1].x, ei[1].y, ei[1].z, ei[1].w};
#pragma unroll
        for (int it = 0; it < 16; ++it) { const unsigned e = (it & 1) ? (ew[it >> 1] >> 16) : (ew[it >> 1] & 0xffffu); rs.rows[it] = *(const u32x4*)(UPS + (size_t)e * 128); }
        const u32x4* cp = (const u32x4*)(COEF + (size_t)t * 128 + r * 16); rs.cw[0] = cp[0]; rs.cw[1] = cp[1];
        rs.gv = *(const f32x2*)(mod + (t >> 13) * 6144 + 5 * 1024 + col); rs.x1v = *(const unsigned*)(out + (size_t)t * D + col); };
    auto compute = [&](int n, const RS& rs) { const int t = wv + n * nwx;
        f32x2 acc[8];
#pragma unroll
        for (int q = 0; q < 8; ++q) { acc[q].x = 0.f; acc[q].y = 0.f; }
        const unsigned cww[8] = {rs.cw[0].x, rs.cw[0].y, rs.cw[0].z, rs.cw[0].w, rs.cw[1].x, rs.cw[1].y, rs.cw[1].z, rs.cw[1].w};
#pragma unroll
        for (int it = 0; it < 16; ++it) { const float ck = (it & 1) ? bf_hi(cww[it >> 1]) : bf_lo(cww[it >> 1]); f32x2 ck2; ck2.x = ck; ck2.y = ck; const unsigned w[4] = {rs.rows[it].x, rs.rows[it].y, rs.rows[it].z, rs.rows[it].w};
#pragma unroll
            for (int q = 0; q < 4; ++q) { const f32x2 lo = __builtin_amdgcn_cvt_pk_f32_fp8((int)w[q], false), hi = __builtin_amdgcn_cvt_pk_f32_fp8((int)w[q], true);
                acc[2 * q] = __builtin_elementwise_fma(ck2, lo, acc[2 * q]); acc[2 * q + 1] = __builtin_elementwise_fma(ck2, hi, acc[2 * q + 1]); } }
        f32x2 a4[4], a2[2], a1;
        { const bool hi = (lane & 32) != 0;
#pragma unroll
            for (int q = 0; q < 4; ++q) { const f32x2 send = hi ? acc[q] : acc[q + 4], keep = hi ? acc[q + 4] : acc[q]; f32x2 recv; recv.x = __shfl_xor(send.x, 32); recv.y = __shfl_xor(send.y, 32); a4[q] = keep + recv; } }
        { const bool hi = (lane & 16) != 0;
#pragma unroll
            for (int q = 0; q < 2; ++q) { const f32x2 send = hi ? a4[q] : a4[q + 2], keep = hi ? a4[q + 2] : a4[q]; f32x2 recv; recv.x = __shfl_xor(send.x, 16); recv.y = __shfl_xor(send.y, 16); a2[q] = keep + recv; } }
        { const bool hi = (lane & 8) != 0; const f32x2 send = hi ? a2[0] : a2[1], keep = hi ? a2[1] : a2[0]; f32x2 recv; recv.x = __shfl_xor(send.x, 8); recv.y = __shfl_xor(send.y, 8); a1 = keep + recv; }
        f32x2 x1f; x1f.x = bf_lo(rs.x1v); x1f.y = bf_hi(rs.x1v); const f32x2 x2f = x1f + rs.gv * a1; const unsigned pk = pk2(x2f.x, x2f.y); *(unsigned*)(out + (size_t)t * D + col) = pk;
        f32x2 x2; x2.x = bf_lo(pk); x2.y = bf_hi(pk);
        const float ss = wave_sum(x2.x * x2.x + x2.y * x2.y);
        if (lane == 0) SSQ[(size_t)t * 8 + x] = ss; };
    ld_idx(0, eiA); ld_idx(1, eiB);
    ld_rows(0, eiA, SA); ld_rows(1, eiB, SB);
    ld_idx(2, eiA); ld_idx(3, eiB);
    for (int n = 0; n < nu; n += 2) {
        compute(n, SA);
        ld_rows(n + 2, eiA, SA); ld_idx(n + 4, eiA);
        compute(n + 1, SB);
        ld_rows(n + 3, eiB, SB); ld_idx(n + 5, eiB);
    }
}
__device__ __forceinline__ void final_norm(const Args& A, int gw, int NGW, int lane) {
    const float* SSQ = (const float*)(A.ws + OFF_SSQ); const float* nfw = A.in[21]; const u16* x2 = (const u16*)(A.ws + OFF_X1); float* out = A.out;
    f32x4 wv[4], s0, s1; u32x2 x[4];
    { const f32x4* w4 = (const f32x4*)nfw + lane;
#pragma unroll
      for (int j = 0; j < 4; ++j) wv[j] = w4[64 * j]; }
    { const int tok = gw < T_LAT ? gw : T_LAT - 1; s0 = *(const f32x4*)(SSQ + (size_t)tok * 8); s1 = *(const f32x4*)(SSQ + (size_t)tok * 8 + 4); const u32x2* i4 = (const u32x2*)(x2 + (size_t)tok * D) + lane;
#pragma unroll
      for (int j = 0; j < 4; ++j) x[j] = i4[64 * j]; }
    for (int tok = gw; tok < T_LAT; tok += NGW) {
        const int tn = tok + NGW < T_LAT ? tok + NGW : tok; u32x2 xn[4];
        const f32x4 n0 = *(const f32x4*)(SSQ + (size_t)tn * 8), n1 = *(const f32x4*)(SSQ + (size_t)tn * 8 + 4); const u32x2* i4 = (const u32x2*)(x2 + (size_t)tn * D) + lane;
#pragma unroll
        for (int j = 0; j < 4; ++j) xn[j] = i4[64 * j];
        const float ss = ((s0.x + s0.y) + (s0.z + s0.w)) + ((s1.x + s1.y) + (s1.z + s1.w));
        const float rstd = 1.f / sqrtf(ss * (1.f / D) + 1e-6f);
        f32x4* o4 = (f32x4*)(out + (size_t)tok * D) + lane;
#pragma unroll
        for (int j = 0; j < 4; ++j) { f32x4 xf; xf.x = bf_lo(x[j].x); xf.y = bf_hi(x[j].x); xf.z = bf_lo(x[j].y); xf.w = bf_hi(x[j].y); o4[64 * j] = xf * rstd * wv[j]; }
#pragma unroll
        for (int j = 0; j < 4; ++j) x[j] = xn[j];
        s0 = n0; s1 = n1;
    }
}

__global__ void __launch_bounds__(NTHREADS) fwd_kernel(Args A) {
    extern __shared__ __attribute__((aligned(16))) unsigned char lds[];
    const int wave = __builtin_amdgcn_readfirstlane((int)threadIdx.x >> 6), bid = blockIdx.x, G = gridDim.x;
#define lane lane_id_asm()
#define tid (wave * 64 + lane)
    const int gw = bid * NWAVES + wave, NGW = G * NWAVES;
    const int lo = A.ph_lo, hi = A.ph_hi;
#if !N_LAUNCH_SPLIT
    volatile unsigned* bst = (volatile unsigned*)(lds + LDS_BYTES - 16);
    if (tid == 0) { bst[0] = 0u; bst[1] = 0u; }
    __syncthreads();
    XcdBarrier bar = xcd_barrier_post((unsigned*)(A.ws + OFF_CTL), bst);
#define GRID_BAR() xcd_barrier(bar)
#else
#define GRID_BAR() do {} while (0)
#endif
#define IN(k) (lo <= (k) && (k) < hi)
#define SEAM(k) do { if (IN(k) && IN((k) + 1)) GRID_BAR(); } while (0)
    const float* mod = (const float*)(A.ws + OFF_MOD);
#define OT(x) opaque_i(x)
    if (IN(0)) { phase0(A, lds, bid, G, OT(tid)); __syncthreads(); }
    if (IN(1)) norm_rows<false, false>(A.in[0], A.in[2], T_ALL, A.in[6], mod, 0, 1, (u16*)(A.ws + OFF_H), OT(gw), NGW, OT(lane), nullptr, nullptr, (unsigned*)(A.ws + OFF_CTL));
    SEAM(1);
    if (IN(2)) { EpiIn e{A.ws}; gemm_phase((const u16*)(A.ws + OFF_H), (const u16*)(A.ws + OFF_WIN), T_ALL / 256, NIN_PAD / 256, lds, e, bid, G, OT(tid)); }
    SEAM(2);
    if (IN(3)) {
        HookDown hd{A.in[19], (unsigned char*)A.out + DOUT_DOWN, (float*)((unsigned char*)A.out + DOUT_DSC), gw, NGW, OT(lane)};
        HookUp hu{A.in[20], (unsigned char*)A.out + DOUT_UP, bid * NTHREADS + OT(tid), G * NTHREADS};
        scan_ret2<0>(A, lds, bid >> 4, bid & 15, OT(tid), hd); __syncthreads(); scan_gla2<0>(A, lds, bid >> 4, bid & 15, OT(tid), hu); }
    SEAM(3);
    if (IN(4)) scan_combine(A, bid, G, OT(tid));
    SEAM(4);
    if (IN(5)) { HookNone hn; scan_ret2<1>(A, lds, bid >> 4, (bid & 15) + 1, OT(tid), hn); __syncthreads(); scan_gla2<1>(A, lds, bid >> 4, (bid & 15) + 1, OT(tid), hn); }
    SEAM(5);
    if (IN(6)) phase4(A, OT(gw), NGW, OT(lane));
    SEAM(6);
    if (IN(7)) { EpiOut e{A.in[0], mod, (u16*)(A.ws + OFF_X1)}; gemm_phase((const u16*)(A.ws + OFF_Y), (const u16*)(A.ws + OFF_WOUT), T_LAT / 256, 1024 / 256, lds, e, bid, G, OT(tid)); }
    SEAM(7);
    if (IN(8)) {
        norm_rows<true, true>((const float*)(A.ws + OFF_X1), nullptr, T_LAT, A.in[7], mod, 3, 4, (u16*)(A.ws + OFF_H2), OT(gw), NGW, OT(lane), A.ws + OFF_H2Q, (float*)(A.ws + OFF_HS));
    }
    SEAM(8);
    if (IN(9)) { EpiQTopk e{A.ws}; gemm_phase((const u16*)(A.ws + OFF_H2), (const u16*)(A.ws + OFF_WQ), T_LAT / 256, 2048 / 256, lds, e, bid, G, OT(tid)); }
    SEAM(9);
    if (IN(10)) gather_down(A, bid, G, wave, OT(lane));
    SEAM(10);
    if (IN(11)) gather_coef(A, bid, G, OT(tid));
    SEAM(11);
    if (IN(12)) gather_up(A, bid, G, wave, OT(lane));
    SEAM(12);
    if (IN(13)) final_norm(A, OT(gw), NGW, OT(lane));
#undef lane
#undef tid
}

extern "C" void kernel_launch(void* const* d_in, const int* in_sizes, int n_in, void* d_out, int out_size, void* d_ws, size_t ws_size, hipStream_t stream) {
    static int grid = 0;
    if (grid == 0) {
        if (n_in != 22 || out_size != T_LAT * D || ws_size < WS_NEED) { fprintf(stderr, "kernel_launch: unexpected shapes (n_in %d out %d ws %zu need %zu)\n", n_in, out_size, ws_size, (size_t)WS_NEED); grid = -1; return; }
        int dev = 0, cus = 0;
        if (hipGetDevice(&dev) != hipSuccess || hipDeviceGetAttribute(&cus, hipDeviceAttributeMultiprocessorCount, dev) != hipSuccess) { grid = -1; return; }
        if (hipFuncSetAttribute((const void*)fwd_kernel, hipFuncAttributeMaxDynamicSharedMemorySize, LDS_BYTES) != hipSuccess) { fprintf(stderr, "kernel_launch: hipFuncSetAttribute failed\n"); grid = -1; return; }
        int per_cu = 0;
        if (hipOccupancyMaxActiveBlocksPerMultiprocessor(&per_cu, (const void*)fwd_kernel, NTHREADS, LDS_BYTES) != hipSuccess || per_cu < 1) { fprintf(stderr, "kernel_launch: occupancy query says %d\n", per_cu); }
        (void)hipGetLastError();
        if (cus < 256) fprintf(stderr, "kernel_launch: %d CUs reported; this kernel is built for 256 (one 512-thread workgroup per CU)\n", cus);
        grid = 256;
    }
    if (grid < 0) return;
    (void)hipMemsetAsync((char*)d_ws + OFF_CTL, 0, CTL_BYTES, stream);
    Args a{};
    for (int i = 0; i < 22; ++i) a.in[i] = (const float*)d_in[i];
    a.out = (float*)d_out; a.ws = (unsigned char*)d_ws; a.rep = 0;
#if N_LAUNCH_SPLIT
    for (int p = 0; p < NPHASES; ++p) { a.ph_lo = p; a.ph_hi = p + 1; hipLaunchKernelGGL(fwd_kernel, dim3(grid), dim3(NTHREADS), LDS_BYTES, stream, a); }
#else
    a.ph_lo = 0; a.ph_hi = NPHASES;
    hipLaunchKernelGGL(fwd_kernel, dim3(grid), dim3(NTHREADS), LDS_BYTES, stream, a);
#endif
}
```

```cpp
#include <hip/hip_runtime.h>
#include <cstdio>
#include <cstdint>

typedef short bf16x8 __attribute__((ext_vector_type(8)));
typedef float f32x16 __attribute__((ext_vector_type(16)));
typedef float f32x4 __attribute__((ext_vector_type(4)));
typedef float f32x2 __attribute__((ext_vector_type(2)));
typedef unsigned u32x4 __attribute__((ext_vector_type(4)));
typedef unsigned u32x2 __attribute__((ext_vector_type(2)));
typedef unsigned short u16;

#ifndef N_LAUNCH_SPLIT
#define N_LAUNCH_SPLIT 0
#endif

constexpr int D = 1024, NBATCH = 2, SEQ = 8192, CTXL = 256;
constexpr int T_LAT = NBATCH * SEQ;
constexpr int T_ALL = T_LAT + NBATCH * CTXL;
constexpr int NIN = 3616, NIN_PAD = 3840;
constexpr int PITCH = 1088;
constexpr int NTHREADS = 512, NWAVES = 8;
constexpr int LDS_BYTES = 132 * 1024;
constexpr int NPHASES = 14;

constexpr size_t OFF_CTL = 0;
constexpr size_t CTL_BYTES = 16 * 1024;
constexpr size_t OFF_MOD = 64 * 1024;
constexpr size_t OFF_TABR = 192 * 1024;
constexpr size_t OFF_TABC = 224 * 1024;
constexpr size_t OFF_WIN = 256 * 1024;
constexpr size_t OFF_WOUT = OFF_WIN + (size_t)NIN_PAD * PITCH * 2;
constexpr size_t OFF_WQ = OFF_WOUT + (size_t)1024 * PITCH * 2;
constexpr size_t OFF_K1 = OFF_WQ + (size_t)2048 * PITCH * 2;
constexpr size_t OFF_K2 = OFF_K1 + (size_t)8 * 128 * 128 * 2;
constexpr size_t OFF_FEAT = OFF_K2 + (size_t)8 * 128 * 128 * 2;
constexpr size_t PL512 = (size_t)T_ALL * 512 * 2, PL256 = (size_t)T_ALL * 256 * 2;
constexpr size_t OFF_RQ = OFF_FEAT, OFF_RK = OFF_RQ + PL512, OFF_RKT = OFF_RK + PL512, OFF_RVT = OFF_RKT + PL512, OFF_RG = OFF_RVT + PL512;
constexpr size_t OFF_GQ = OFF_RG + PL512, OFF_GK = OFF_GQ + PL256, OFF_GKT = OFF_GK + PL256, OFF_GVT = OFF_GKT + PL256, OFF_GG = OFF_GVT + PL512;
constexpr size_t OFF_LR = OFF_GG + PL512;
constexpr size_t OFF_O = OFF_LR + (size_t)T_ALL * 32 * 4;
constexpr size_t OPL = (size_t)T_LAT * 512 * 2;
constexpr size_t OFF_ORF = OFF_O, OFF_ORB = OFF_ORF + OPL, OFF_OGF = OFF_ORB + OPL, OFF_OGB = OFF_OGF + OPL;
constexpr size_t OFF_H = OFF_O;
constexpr size_t OFF_Y = OFF_RQ;
constexpr size_t OFF_SLOT_R = OFF_OGB + OPL;
constexpr size_t OFF_SLOT_G = OFF_SLOT_R + (size_t)16 * 16 * 65536;
constexpr size_t OFF_GSUM = OFF_SLOT_G + (size_t)16 * 16 * 32768;
constexpr size_t WS_END_A = OFF_GSUM + 65536;
constexpr size_t OFF_H2 = OFF_FEAT;
constexpr size_t OFF_QB = OFF_H2 + (size_t)T_LAT * PITCH * 2;
constexpr size_t OFF_IDX = OFF_QB;
constexpr size_t OFF_GW = OFF_IDX + (size_t)T_LAT * 128 * 4;
constexpr size_t OFF_X1 = OFF_GW + (size_t)T_LAT * 128 * 4;
constexpr size_t OFF_UPB = OFF_X1 + (size_t)16384 * 1024 * 2;
constexpr size_t DOUT_DOWN = 0, DOUT_UP = (size_t)16384 * 1024, DOUT_DSC = (size_t)2 * 16384 * 1024;
constexpr size_t OFF_COEF = OFF_UPB + (size_t)16384 * 1024 * 2;
constexpr size_t OFF_SSQ = OFF_COEF + (size_t)T_LAT * 128 * 4;
constexpr size_t OFF_PART = OFF_SSQ + (size_t)T_LAT * 8 * 4;
constexpr size_t OFF_H2Q = OFF_PART + (size_t)8 * T_LAT * 128 * 2;
constexpr size_t OFF_HS = OFF_H2Q + (size_t)T_LAT * 1024;
constexpr size_t OFF_DSC = OFF_HS + (size_t)T_LAT * 4;
constexpr size_t WS_END_B = OFF_DSC + (size_t)16384 * 4;
constexpr size_t WS_NEED = WS_END_A > WS_END_B ? WS_END_A : WS_END_B;
static_assert(WS_NEED <= (size_t)256 * 1024 * 1024, "workspace map exceeds the guaranteed 256 MiB");
static_assert((size_t)T_ALL * PITCH * 2 <= 4 * OPL && (size_t)T_LAT * PITCH * 2 <= 3 * PL512, "H / Y aliases");

constexpr float UP_SCALE = 64.f;
__device__ const double ROPE_INV[32] = {1.0, 0.7498942093324559, 0.5623413251903491, 0.4216965034285822, 0.31622776601683794, 0.23713737056616552, 0.1778279410038923, 0.1333521432163324, 0.1, 0.07498942093324558, 0.05623413251903491, 0.042169650342858224, 0.03162277660168379, 0.023713737056616554, 0.01778279410038923, 0.01333521432163324, 0.01, 0.007498942093324558, 0.005623413251903491, 0.004216965034285823, 0.0031622776601683794, 0.0023713737056616554, 0.0017782794100389228, 0.001333521432163324, 0.001, 0.0007498942093324559, 0.0005623413251903491, 0.00042169650342858224, 0.00031622776601683794, 0.00023713737056616554, 0.00017782794100389227, 0.0001333521432163324};

struct Args { const float* in[22]; float* out; unsigned char* ws; int ph_lo, ph_hi; int rep, pad; };

__device__ __forceinline__ int lane_id_asm() { int x; asm volatile("v_mbcnt_lo_u32_b32 %0, -1, 0\n\tv_mbcnt_hi_u32_b32 %0, -1, %0" : "=v"(x)); return x; }
__device__ __forceinline__ int opaque_i(int x) { asm volatile("" : "+v"(x)); return x; }
typedef __bf16 bf16x2_t __attribute__((ext_vector_type(2)));
__device__ __forceinline__ unsigned pk2(float lo, float hi) { f32x2 f; f.x = lo; f.y = hi; const bf16x2_t v = __builtin_convertvector(f, bf16x2_t); return __builtin_bit_cast(unsigned, v); }
typedef _Float16 f16x2_t __attribute__((ext_vector_type(2)));
__device__ __forceinline__ unsigned pkh2(float a, float b) { f32x2 v; v.x = a; v.y = b; const f16x2_t h = __builtin_convertvector(v, f16x2_t); return __builtin_bit_cast(unsigned, h); }
__device__ __forceinline__ f32x2 unpkh2(unsigned u) { const f16x2_t h = __builtin_bit_cast(f16x2_t, u); return __builtin_convertvector(h, f32x2); }
__device__ __forceinline__ float bf_lo(unsigned u) { return __uint_as_float(u << 16); }
__device__ __forceinline__ float bf_hi(unsigned u) { return __uint_as_float(u & 0xffff0000u); }
__device__ __forceinline__ u16 bf1(float x) { return (u16)(pk2(x, 0.f) & 0xffffu); }
__device__ __forceinline__ float wave_max(float v) {
#pragma unroll
    for (int o = 1; o < 64; o <<= 1) v = fmaxf(v, __shfl_xor(v, o));
    return v;
}
__device__ __forceinline__ unsigned q8x4(float a, float b, float c, float d, float sc) {
    const int ia = (int)rintf(a * sc), ib = (int)rintf(b * sc), ic = (int)rintf(c * sc), id = (int)rintf(d * sc);
    return ((unsigned)ia & 0xffu) | (((unsigned)ib & 0xffu) << 8) | (((unsigned)ic & 0xffu) << 16) | ((unsigned)id << 24);
}
__device__ __forceinline__ float wave_sum(float v) {
#pragma unroll
    for (int o = 1; o < 64; o <<= 1) v += __shfl_xor(v, o);
    return v;
}
__device__ __forceinline__ float silu_f(float x) { return x / (1.f + expf(-x)); }
__device__ __forceinline__ float logsig_f(float x) { return fminf(x, 0.f) - log1pf(expf(-fabsf(x))); }
__device__ __forceinline__ float logsig_fast(float x) { return fminf(x, 0.f) - __logf(1.f + __expf(-fabsf(x))); }
__device__ __forceinline__ float silu_fast(float x) { return x * __builtin_amdgcn_rcpf(1.f + __expf(-x)); }
#define MFMA(a, b, c) __builtin_amdgcn_mfma_f32_32x32x16_bf16((a), (b), (c), 0, 0, 0)
__device__ __forceinline__ int acc_row(int r, int hh) { return (r & 3) + 8 * (r >> 2) + 4 * hh; }

__device__ __forceinline__ int off128(int r, int c) { return r * 128 + ((c ^ ((r >> 1) & 7)) << 4); }
__device__ __forceinline__ int off256(int r, int c) { return r * 256 + ((c ^ (r & 15)) << 4); }

#define XB_TMO      128
#define XB_XCNT(j)  (256  + 64 * (j))
#define XB_XSUB(j)  (1280 + 64 * (j))
#define XB_XGEN(j)  (2304 + 64 * (j))
#define XB_TOP      3328
#define XB_TOPGEN   3392
#define XCD_BAR_WORDS 3456
#define XB_MODCNT   3520
#define XB_SPIN_CAP (1u << 22)
__device__ __forceinline__ unsigned xb_ld(unsigned* p)              { return __hip_atomic_load(p, __ATOMIC_RELAXED, __HIP_MEMORY_SCOPE_AGENT); }
__device__ __forceinline__ unsigned xb_add(unsigned* p, unsigned v) { return __hip_atomic_fetch_add(p, v, __ATOMIC_RELAXED, __HIP_MEMORY_SCOPE_AGENT); }
__device__ __forceinline__ unsigned xb_xcc_id() { return (unsigned)__builtin_amdgcn_s_getreg((3 << 11) | 20) & 0xFu; }
#define XB_SPIN(cond, bar) do { unsigned _sp = 0; while (cond) { __builtin_amdgcn_s_sleep(1); \
    if ((++_sp & 255u) == 0u) { if (xb_ld(&(bar)[XB_TMO])) break; if (_sp > XB_SPIN_CAP) { atomicAdd(&(bar)[XB_TMO], 1u); break; } } } } while (0)
struct XcdBarrier { unsigned* bar; unsigned x; volatile unsigned* st; };
__device__ __forceinline__ XcdBarrier xcd_barrier_post(unsigned* bar, volatile unsigned* st) {
    XcdBarrier b; b.bar = bar; b.x = xb_xcc_id(); b.st = st;
    if (threadIdx.x == 0) (void)xb_add(&bar[XB_XCNT(b.x)], 1u);
    return b;
}
__device__ __forceinline__ void xcd_barrier_complete(unsigned* bar, unsigned x, unsigned& nloc, unsigned& nx) {
    const unsigned G = gridDim.x * gridDim.y * gridDim.z;
    unsigned sum, cnt, mine, sp = 0u;
    for (;;) {
        sum = 0u; cnt = 0u; mine = 0u;
#pragma unroll
        for (unsigned j = 0; j < 16; ++j) { const unsigned c = xb_ld(&bar[XB_XCNT(j)]); sum += c; cnt += (c > 0u) ? 1u : 0u; mine = (j == x) ? c : mine; }
        if (sum == G) break;
        __builtin_amdgcn_s_sleep(1);
        if ((++sp & 255u) == 0u) { if (xb_ld(&bar[XB_TMO])) break; if (sp > XB_SPIN_CAP) { atomicAdd(&bar[XB_TMO], 1u); break; } }
    }
    nloc = mine > 0u ? mine : 1u; nx = cnt > 0u ? cnt : 1u;
}
__device__ __forceinline__ void xcd_barrier(const XcdBarrier& b) {
    asm volatile("s_waitcnt vmcnt(0)" ::: "memory");
    __syncthreads();
    if (threadIdx.x == 0) {
        unsigned* bar = b.bar;
        __builtin_amdgcn_s_waitcnt(0);
        unsigned nloc = b.st[0], nx = b.st[1];
        if (nloc == 0u) { xcd_barrier_complete(bar, b.x, nloc, nx); b.st[0] = nloc; b.st[1] = nx; }
        const unsigned old = xb_add(&bar[XB_XSUB(b.x)], 1u);
        const unsigned gen = old / nloc;
        if (old + 1u == (gen + 1u) * nloc) {
            __builtin_amdgcn_fence(__ATOMIC_RELEASE, "agent");
            asm volatile("s_waitcnt vmcnt(0)" ::: "memory");
            const unsigned og = xb_add(&bar[XB_TOP], 1u);
            const unsigned tg = og / nx;
            if (og + 1u == (tg + 1u) * nx) xb_add(&bar[XB_TOPGEN], 1u);
            else XB_SPIN(xb_ld(&bar[XB_TOPGEN]) == tg, bar);
            __builtin_amdgcn_fence(__ATOMIC_ACQUIRE, "agent");
            xb_add(&bar[XB_XGEN(b.x)], 1u);
            asm volatile("s_waitcnt vmcnt(0)" ::: "memory");
        } else {
            XB_SPIN(xb_ld(&bar[XB_XGEN(b.x)]) == gen, bar);
            __builtin_amdgcn_fence(__ATOMIC_ACQUIRE, "agent");
            asm volatile("s_waitcnt vmcnt(0)" ::: "memory");
        }
    }
    __syncthreads();
}

constexpr int NGEMV = 192;
__device__ __forceinline__ void transpose_item64(const float* W, int N, int nvalid, int n0, u16* WT, int k0, int lane) {
    const int n = n0 + lane; const bool ok = n < nvalid; const int nl = ok ? n : 0;
    float v[64];
#pragma unroll
    for (int i = 0; i < 64; ++i) { const float* rowp = W + (size_t)(k0 + i) * N; v[i] = rowp[nl]; }
    u32x4* o = (u32x4*)(WT + (size_t)n * PITCH + k0);
#pragma unroll
    for (int j = 0; j < 8; ++j) { u32x4 q; q.x = pk2(v[8 * j], v[8 * j + 1]); q.y = pk2(v[8 * j + 2], v[8 * j + 3]); q.z = pk2(v[8 * j + 4], v[8 * j + 5]); q.w = pk2(v[8 * j + 6], v[8 * j + 7]);
        if (!ok) { q.x = 0u; q.y = 0u; q.z = 0u; q.w = 0u; }
        o[j] = q; }
}
__device__ __forceinline__ void sincos_d(double a, float& c, float& s) {
    const double TWO_PI = 6.283185307179586476925287;
    a -= rint(a / TWO_PI) * TWO_PI;
    const double x2 = a * a;
    double sc = 1.0, ss = 1.0;
#pragma unroll
    for (int k = 15; k >= 1; --k) { sc = 1.0 - sc * x2 / (double)((2 * k - 1) * (2 * k)); ss = 1.0 - ss * x2 / (double)((2 * k) * (2 * k + 1)); }
    c = (float)sc; s = (float)(ss * a);
}
__device__ __forceinline__ void phase0(const Args& A, unsigned char* lds, int bid, int G, int tid) {
    const int lane = tid & 63, wave = tid >> 6;
    const float* c = A.in[1]; const float* c_ctx = A.in[3]; const float* w_mod = A.in[4]; const float* b_mod = A.in[5];
    float* mod = (float*)(A.ws + OFF_MOD);
    if (bid < NGEMV) {
        float* sv = (float*)lds;
        float* red = sv + 3072;
        for (int i = tid; i < 3072; i += NTHREADS) { const int v = i >> 10, k = i & 1023; const float x = (v < 2) ? c[v * 1024 + k] : c_ctx[k]; sv[i] = silu_f(x); }
        const int c0 = bid * 32, kr = lane >> 3, cq = (lane & 7) * 4;
        const float* wp = w_mod + (size_t)(wave * 128 + kr) * 6144 + c0 + cq;
        f32x4 wv[16];
#pragma unroll
        for (int i = 0; i < 16; ++i) wv[i] = *(const f32x4*)(wp + (size_t)(8 * i) * 6144);
        __syncthreads();
        f32x4 a0 = {0.f, 0.f, 0.f, 0.f}, a1 = a0, a2 = a0;
#pragma unroll
        for (int i = 0; i < 16; ++i) { const int kk = wave * 128 + 8 * i + kr; a0 += wv[i] * sv[kk]; a1 += wv[i] * sv[1024 + kk]; a2 += wv[i] * sv[2048 + kk]; }
#pragma unroll
        for (int m = 8; m < 64; m <<= 1) {
            a0.x += __shfl_xor(a0.x, m); a0.y += __shfl_xor(a0.y, m); a0.z += __shfl_xor(a0.z, m); a0.w += __shfl_xor(a0.w, m);
            a1.x += __shfl_xor(a1.x, m); a1.y += __shfl_xor(a1.y, m); a1.z += __shfl_xor(a1.z, m); a1.w += __shfl_xor(a1.w, m);
            a2.x += __shfl_xor(a2.x, m); a2.y += __shfl_xor(a2.y, m); a2.z += __shfl_xor(a2.z, m); a2.w += __shfl_xor(a2.w, m); }
        if (lane < 8) { *(f32x4*)(red + (wave * 3 + 0) * 32 + cq) = a0; *(f32x4*)(red + (wave * 3 + 1) * 32 + cq) = a1; *(f32x4*)(red + (wave * 3 + 2) * 32 + cq) = a2; }
        __syncthreads();
        if (tid < 96) { const int v = tid >> 5, l = tid & 31; float sacc = b_mod[c0 + l];
#pragma unroll
            for (int w = 0; w < 8; ++w) sacc += red[(w * 3 + v) * 32 + l];
            mod[v * 6144 + c0 + l] = sacc; }
        asm volatile("s_waitcnt vmcnt(0)" ::: "memory"); __syncthreads();
        if (tid == 0) { __builtin_amdgcn_fence(__ATOMIC_RELEASE, "agent"); (void)xb_add((unsigned*)(A.ws + OFF_CTL) + XB_MODCNT, 1u); }
    }
    {
        const int vb = bid >= NGEMV ? bid - NGEMV : bid + (G - NGEMV);
        constexpr int I_IN = 16 * (NIN_PAD / 64), I_OUT = 16 * 16, I_Q = 16 * 32;
        u16* win_t = (u16*)(A.ws + OFF_WIN); u16* wout_t = (u16*)(A.ws + OFF_WOUT); u16* wq_t = (u16*)(A.ws + OFF_WQ);
        for (int it = vb * NWAVES + wave; it < I_IN + I_OUT + I_Q; it += G * NWAVES) {
            int r = it;
            if (r < I_IN) { transpose_item64(A.in[8], NIN, NIN, (r % (NIN_PAD / 64)) * 64, win_t, (r / (NIN_PAD / 64)) * 64, lane); continue; }
            r -= I_IN;
            if (r < I_OUT) { transpose_item64(A.in[15], 1024, 1024, (r % 16) * 64, wout_t, (r / 16) * 64, lane); continue; }
            r -= I_OUT;
            transpose_item64(A.in[16], 2048, 2048, (r % 32) * 64, wq_t, (r / 32) * 64, lane);
        }
        const int gt = vb * NTHREADS + tid, NGT = G * NTHREADS;
        for (int i = gt; i < 2 * 16384; i += NGT) { const int which = i >> 14, ch = i & 16383; const int hh_ = ch & 1; const float* src = A.in[17 + which] + (size_t)(ch >> 1) * 16 + 4 * hh_;
            const f32x4 a = *(const f32x4*)src, b = *(const f32x4*)(src + 8); u32x4 o; o.x = pk2(a.x, a.y); o.y = pk2(a.z, a.w); o.z = pk2(b.x, b.y); o.w = pk2(b.z, b.w);
            *(u32x4*)(A.ws + (which ? OFF_K2 : OFF_K1) + (size_t)ch * 16) = o; }
        for (int i = gt - 64 * NTHREADS; i >= 0 && i < 192 * 32; i += NGT) { const int p = i >> 5, f = i & 31; float cs, sn; const int pos = p < 128 ? p : p - 128; sincos_d((double)pos * ROPE_INV[f], cs, sn);
            f32x2* t = (f32x2*)(A.ws + (p < 128 ? OFF_TABR : OFF_TABC)) + pos * 32 + f; f32x2 v; v.x = cs; v.y = sn; *t = v; }
    }
}

__device__ __forceinline__ int xcd_row(int i, int gw, int NGW) {
    const int bid = gw >> 3, wave = gw & 7, x = bid & 7, wl = (bid >> 3) * 8 + wave;
    const int ra = 2048 * x + wl + 256 * i, rb = 16384 + gw + 2048 * (i - 8), rc = gw + i * NGW;
    return (NGW == 2048) ? (i < 8 ? ra : rb) : rc;
}
template <bool Q8, bool BFIN>
__device__ __forceinline__ void norm_rows(const float* src_lat, const float* src_ctx, int nrows, const float* w, const float* mod, int shift_idx, int scale_idx, u16* dst, int gw, int NGW, int lane, unsigned char* q8 = nullptr, float* qs = nullptr, unsigned* ctl = nullptr) {
    const int niter_ = (NGW == 2048) ? (nrows > 16384 ? 9 : 8) : (nrows + NGW - 1) / NGW;
    f32x4 x[4], mul[4], shf[4]; u32x2 xb[4]; int vcur = -1;
    int r = xcd_row(0, gw, NGW);
    { const int rc = r < nrows ? r : nrows - 1;
      if (BFIN) { const u32x2* s2 = (const u32x2*)((const u16*)src_lat + (size_t)rc * D) + lane;
#pragma unroll
          for (int j = 0; j < 4; ++j) xb[j] = s2[64 * j]; }
      else { const f32x4* s4 = (const f32x4*)(rc < T_LAT ? src_lat + (size_t)rc * D : src_ctx + (size_t)(rc - T_LAT) * D) + lane;
#pragma unroll
          for (int j = 0; j < 4; ++j) x[j] = s4[64 * j]; } }
    for (int i_ = 0; i_ < niter_; ++i_) {
        const int rn = i_ + 1 < niter_ ? xcd_row(i_ + 1, gw, NGW) : nrows; f32x4 xn[4]; u32x2 xbn[4];
        { const int rc = rn < nrows ? rn : nrows - 1;
          if (BFIN) { const u32x2* s2 = (const u32x2*)((const u16*)src_lat + (size_t)rc * D) + lane;
#pragma unroll
              for (int j = 0; j < 4; ++j) xbn[j] = s2[64 * j]; }
          else { const f32x4* s4 = (const f32x4*)(rc < T_LAT ? src_lat + (size_t)rc * D : src_ctx + (size_t)(rc - T_LAT) * D) + lane;
#pragma unroll
              for (int j = 0; j < 4; ++j) xn[j] = s4[64 * j]; } }
        if (BFIN) {
#pragma unroll
            for (int j = 0; j < 4; ++j) { x[j].x = bf_lo(xb[j].x); x[j].y = bf_hi(xb[j].x); x[j].z = bf_lo(xb[j].y); x[j].w = bf_hi(xb[j].y); } }
        if (r < nrows) {
            const int v = r < T_LAT ? (r >> 13) : 2;
            if (v != vcur) {
                if (ctl != nullptr && vcur < 0) { if (threadIdx.x == 0) { XB_SPIN(xb_ld(&ctl[XB_MODCNT]) < (unsigned)NGEMV, ctl); __builtin_amdgcn_fence(__ATOMIC_ACQUIRE, "agent"); } __syncthreads(); }
                vcur = v; const f32x4* w4 = (const f32x4*)w + lane; const f32x4* sh4 = (const f32x4*)(mod + v * 6144 + shift_idx * 1024) + lane; const f32x4* sc4 = (const f32x4*)(mod + v * 6144 + scale_idx * 1024) + lane;
#pragma unroll
                for (int j = 0; j < 4; ++j) { mul[j] = w4[64 * j] * (sc4[64 * j] + 1.f); shf[j] = sh4[64 * j]; } }
            float ss = 0.f;
#pragma unroll
            for (int j = 0; j < 4; ++j) ss += (x[j].x * x[j].x + x[j].y * x[j].y) + (x[j].z * x[j].z + x[j].w * x[j].w);
            const float rstd = 1.f / sqrtf(wave_sum(ss) * (1.f / D) + 1e-6f);
            u32x2* o = (u32x2*)(dst + (size_t)r * PITCH) + lane; f32x4 y[4]; float mx = 0.f;
#pragma unroll
            for (int j = 0; j < 4; ++j) { y[j] = x[j] * rstd * mul[j] + shf[j];
                u32x2 p; p.x = pk2(y[j].x, y[j].y); p.y = pk2(y[j].z, y[j].w); o[64 * j] = p;
                if (Q8) mx = fmaxf(mx, fmaxf(fmaxf(fabsf(y[j].x), fabsf(y[j].y)), fmaxf(fabsf(y[j].z), fabsf(y[j].w)))); }
            if (Q8) {
                mx = fmaxf(wave_max(mx), 1e-20f); const float qsc = 127.f / mx; unsigned* qo = (unsigned*)(q8 + (size_t)r * D) + lane;
#pragma unroll
                for (int j = 0; j < 4; ++j) qo[64 * j] = q8x4(y[j].x, y[j].y, y[j].z, y[j].w, qsc);
                if (lane == 0) qs[r] = mx * (1.f / 127.f); }
        }
#pragma unroll
        for (int j = 0; j < 4; ++j) { if (BFIN) xb[j] = xbn[j]; else x[j] = xn[j]; }
        r = rn;
    }
}

#define RAW_BARRIER() do { __builtin_amdgcn_s_waitcnt(0xC07F)  ; asm volatile("" ::: "memory"); __builtin_amdgcn_s_barrier(); asm volatile("" ::: "memory"); } while (0)
template <class Epi>
__device__ __forceinline__ void gemm_phase(const u16* Ag_, const u16* Bg_, int Mtiles, int Ntiles, unsigned char* lds, const Epi& epi, int bid, int G, int tid) {
    const int lane = tid & 63, wave = __builtin_amdgcn_readfirstlane(tid >> 6), wm = wave >> 1, wn = wave & 1, l31 = lane & 31, hh = lane >> 5;
    const bool xo = (G == 256); const int xcd = bid & 7, jx = bid >> 3, mper = Mtiles >> 3, nmain = xo ? mper * Ntiles : Mtiles * Ntiles, nextra = xo ? (Mtiles - mper * 8) * Ntiles : 0;
    const int srow = wave * 32 + (lane >> 2), sc = ((lane & 3) ^ ((lane >> 4) & 3)) * 8;
    const int fsw = (l31 >> 2) & 3;
    const int koff = xo ? (((jx & 7) + (jx >> 3)) & 1) : 0;
    for (int q = xo ? jx : bid; q < nmain + ((nextra + 7) >> 3); q += xo ? 32 : G) {
        int mt, nt;
        if (!xo) { mt = q / Ntiles; nt = q % Ntiles; }
        else if (q < nmain) { mt = xcd * mper + q % mper; nt = q / mper; }
        else { const int e = (q - nmain) * 8 + xcd; if (e >= nextra) continue; mt = mper * 8 + e / Ntiles; nt = e % Ntiles; }
        const int so_ = opaque_i(srow * PITCH + sc);
        const u16* Ag = Ag_ + (size_t)mt * (256 * PITCH) + so_; const u16* Bg = Bg_ + (size_t)nt * (256 * PITCH) + so_;
        f32x16 acc[4][2];
#pragma unroll
        for (int i = 0; i < 4; ++i)
#pragma unroll
            for (int j = 0; j < 2; ++j)
#pragma unroll
                for (int r = 0; r < 16; ++r) acc[i][j][r] = 0.f;
        asm volatile("s_waitcnt vmcnt(0)" ::: "memory");
#define GEMM_ISSUE(kt_) do { unsigned char* st_ = lds + ((kt_) & 3) * 32768 + wave * 2048; \
        __builtin_amdgcn_global_load_lds((const unsigned*)(Ag + (((kt_) + koff) & 31) * 32), (__attribute__((address_space(3))) unsigned*)(st_), 16, 0, 0); \
        __builtin_amdgcn_global_load_lds((const unsigned*)(Ag + (((kt_) + koff) & 31) * 32 + 16 * PITCH), (__attribute__((address_space(3))) unsigned*)(st_ + 1024), 16, 0, 0); \
        __builtin_amdgcn_global_load_lds((const unsigned*)(Bg + (((kt_) + koff) & 31) * 32), (__attribute__((address_space(3))) unsigned*)(st_ + 16384), 16, 0, 0); \
        __builtin_amdgcn_global_load_lds((const unsigned*)(Bg + (((kt_) + koff) & 31) * 32 + 16 * PITCH), (__attribute__((address_space(3))) unsigned*)(st_ + 16384 + 1024), 16, 0, 0); } while (0)
        GEMM_ISSUE(0); GEMM_ISSUE(1); GEMM_ISSUE(2);
#define GEMM_LOADF(F_, kt_, ks_) do { const unsigned char* Ac_ = lds + ((kt_) & 3) * 32768; const unsigned char* Bc_ = Ac_ + 16384; const int co_ = ((((ks_) * 2 + hh) ^ fsw) << 4); \
        _Pragma("unroll") for (int tm = 0; tm < 2; ++tm) F_##a[tm] = *(const bf16x8*)(Ac_ + (wm * 64 + tm * 32 + l31) * 64 + co_); \
        _Pragma("unroll") for (int tn = 0; tn < 4; ++tn) F_##b[tn] = *(const bf16x8*)(Bc_ + (wn * 128 + tn * 32 + l31) * 64 + co_); } while (0)
#define GEMM_MFMA(F_) do { _Pragma("unroll") for (int tn = 0; tn < 4; ++tn) _Pragma("unroll") for (int tm = 0; tm < 2; ++tm) acc[tn][tm] = MFMA(F_##b[tn], F_##a[tm], acc[tn][tm]); } while (0)
        bf16x8 F0a[2], F0b[4], F1a[2], F1b[4], F2a[2], F2b[4];
        asm volatile("s_waitcnt vmcnt(8)" ::: "memory"); RAW_BARRIER();
        GEMM_LOADF(F0, 0, 0);
#define LDA_(F_, tm_, kt_, ks_) F_##a[tm_] = *(const bf16x8*)(lds + ((kt_) & 3) * 32768 + (wm * 64 + (tm_) * 32 + l31) * 64 + ((((ks_) * 2 + hh) ^ fsw) << 4))
#define LDB_(F_, tn_, kt_, ks_) F_##b[tn_] = *(const bf16x8*)(lds + ((kt_) & 3) * 32768 + 16384 + (wn * 128 + (tn_) * 32 + l31) * 64 + ((((ks_) * 2 + hh) ^ fsw) << 4))
#define MF_(F_, tn_, tm_) acc[tn_][tm_] = MFMA(F_##b[tn_], F_##a[tm_], acc[tn_][tm_])
#define SB_() __builtin_amdgcn_sched_barrier(0)
#define GEMM_STEP(CUR, NXT, kt_) do { \
            if ((kt_) < 31) { if ((kt_) < 30) asm volatile("s_waitcnt vmcnt(4)" ::: "memory"); else asm volatile("s_waitcnt vmcnt(0)" ::: "memory"); \
                RAW_BARRIER(); if ((kt_) + 3 < 32 && wave < 4) GEMM_ISSUE((kt_) + 3); } \
            SB_(); LDA_(F1, 0, kt_, 1); LDB_(F1, 0, kt_, 1); SB_(); MF_(CUR, 0, 0); SB_(); \
            LDA_(F1, 1, kt_, 1); LDB_(F1, 1, kt_, 1); SB_(); MF_(CUR, 0, 1); SB_(); \
            LDB_(F1, 2, kt_, 1); LDB_(F1, 3, kt_, 1); SB_(); MF_(CUR, 1, 0); SB_(); \
            if ((kt_) < 31) { LDA_(NXT, 0, (kt_) + 1, 0); LDB_(NXT, 0, (kt_) + 1, 0); } SB_(); MF_(CUR, 1, 1); SB_(); \
            if ((kt_) < 31) { LDA_(NXT, 1, (kt_) + 1, 0); LDB_(NXT, 1, (kt_) + 1, 0); } SB_(); MF_(CUR, 2, 0); SB_(); \
            if ((kt_) < 31) { LDB_(NXT, 2, (kt_) + 1, 0); LDB_(NXT, 3, (kt_) + 1, 0); } SB_(); MF_(CUR, 2, 1); MF_(CUR, 3, 0); MF_(CUR, 3, 1); SB_(); \
            MF_(F1, 0, 0); MF_(F1, 0, 1); MF_(F1, 1, 0); MF_(F1, 1, 1); SB_(); \
            if ((kt_) + 3 < 32 && wave >= 4) GEMM_ISSUE((kt_) + 3); SB_(); \
            MF_(F1, 2, 0); MF_(F1, 2, 1); MF_(F1, 3, 0); MF_(F1, 3, 1); SB_(); } while (0)
        for (int kt = 0; kt < 32; kt += 2) { GEMM_STEP(F0, F2, kt); GEMM_STEP(F2, F0, kt + 1); }
        __syncthreads();
        epi(acc, mt, nt, wm, wn, l31, hh, lds, tid);
    }
}

struct EpiIn {
    unsigned char* ws;
    __device__ __forceinline__ void operator()(f32x16 (&acc)[4][2], int mt, int nt, int wm_, int wn_, int l31_, int hh_, unsigned char* lds, int tid_) const {
        const int wm = opaque_i(wm_), wn = opaque_i(wn_), l31 = opaque_i(l31_), hh = opaque_i(hh_), tid = opaque_i(tid_);
        u16* RQ = (u16*)(ws + OFF_RQ); u16* RK = (u16*)(ws + OFF_RK); u16* RKT = (u16*)(ws + OFF_RKT); u16* RVT = (u16*)(ws + OFF_RVT); u16* RG = (u16*)(ws + OFF_RG);
        u16* GQ = (u16*)(ws + OFF_GQ); u16* GK = (u16*)(ws + OFF_GK); u16* GKT = (u16*)(ws + OFF_GKT); u16* GVT = (u16*)(ws + OFF_GVT); u16* GG = (u16*)(ws + OFF_GG);
        float* LR = (float*)(ws + OFF_LR);
        const int lane = tid & 63; unsigned char* wl = lds + (tid >> 6) * 16384;
        const int m0 = mt * 256 + wm * 64;
        const bool lat = m0 < T_LAT;
        const int nb = nt * 2 + wn;
        auto put_nat = [&](int tn, int tm, int g, u32x2 p) { const int m = tm * 32 + l31; *(u32x2*)(wl + m * 256 + (((tn * 4 + g) ^ (m & 15)) << 4) + hh * 8) = p; };
        auto put_tr = [&](int tn, int tm, int g, u32x2 p) { u16* t = (u16*)(wl + (tn * 32 + 8 * g + 4 * hh) * 128 + (tm * 32 + l31) * 2);
            t[0] = (u16)(p.x & 0xffffu); t[64] = (u16)(p.x >> 16); t[128] = (u16)(p.y & 0xffffu); t[192] = (u16)(p.y >> 16); };
        auto flush_nat = [&](u16* plane, int ld, int col0) {
            asm volatile("s_waitcnt lgkmcnt(0)" ::: "memory"); __builtin_amdgcn_wave_barrier();
#pragma unroll
            for (int i = 0; i < 16; ++i) { const int m = i * 4 + (lane >> 4), ch = lane & 15; const u32x4 v = *(const u32x4*)(wl + m * 256 + ((ch ^ (m & 15)) << 4));
                *(u32x4*)(plane + (size_t)(m0 + m) * ld + col0 + ch * 8) = v; }
            asm volatile("s_waitcnt lgkmcnt(0)" ::: "memory"); __builtin_amdgcn_wave_barrier(); };
        auto flush_tr = [&](u16* planeT, int row0) {
            asm volatile("s_waitcnt lgkmcnt(0)" ::: "memory"); __builtin_amdgcn_wave_barrier();
#pragma unroll
            for (int i = 0; i < 16; ++i) { const int n = i * 8 + (lane >> 3), ch = lane & 7; const u32x4 v = *(const u32x4*)(wl + n * 128 + ch * 16);
                *(u32x4*)(planeT + (size_t)(row0 + n) * T_ALL + m0 + ch * 8) = v; }
            asm volatile("s_waitcnt lgkmcnt(0)" ::: "memory"); __builtin_amdgcn_wave_barrier(); };
        if (nb < 8) {
            const int head = nb & 3; const bool isK = nb >= 4; const float s = isK ? 0.08838834764831845f : 1.f;
            const f32x2* tabR = (const f32x2*)(ws + OFF_TABR); const f32x2* tabC = (const f32x2*)(ws + OFF_TABC);
#pragma unroll
            for (int tm = 0; tm < 2; ++tm) {
                const int m = m0 + tm * 32 + l31; const int l = m & (SEQ - 1);
#pragma unroll
                for (int tn = 0; tn < 2; ++tn) {
                    const f32x2* tab = (tn == 0) ? tabR + (l >> 6) * 32 : tabC + (l & 63) * 32;
#pragma unroll
                    for (int r = 0; r < 16; ++r) { const float a = acc[tn][tm][r] * s, b = acc[tn + 2][tm][r] * s;
                        if (lat) { const f32x2 cs = tab[acc_row(r, hh)]; acc[tn][tm][r] = a * cs.x - b * cs.y; acc[tn + 2][tm][r] = b * cs.x + a * cs.y; } else { acc[tn][tm][r] = a; acc[tn + 2][tm][r] = b; } }
                }
            }
#pragma unroll
            for (int tn = 0; tn < 4; ++tn)
#pragma unroll
                for (int tm = 0; tm < 2; ++tm)
#pragma unroll
                    for (int g = 0; g < 4; ++g) { u32x2 p; p.x = pk2(acc[tn][tm][4 * g], acc[tn][tm][4 * g + 1]); p.y = pk2(acc[tn][tm][4 * g + 2], acc[tn][tm][4 * g + 3]); put_nat(tn, tm, g, p); }
            flush_nat(isK ? RK : RQ, 512, head * 128);
            if (isK) {
#pragma unroll
                for (int tn = 0; tn < 4; ++tn)
#pragma unroll
                    for (int tm = 0; tm < 2; ++tm)
#pragma unroll
                        for (int g = 0; g < 4; ++g) { u32x2 p; p.x = pk2(acc[tn][tm][4 * g], acc[tn][tm][4 * g + 1]); p.y = pk2(acc[tn][tm][4 * g + 2], acc[tn][tm][4 * g + 3]); put_tr(tn, tm, g, p); }
                flush_tr(RKT, head * 128);
            }
        } else if (nb >= 28) {
            if (nb == 28) {
#pragma unroll
                for (int tm = 0; tm < 2; ++tm) { const int m = m0 + tm * 32 + l31;
#pragma unroll
                    for (int g = 0; g < 4; ++g) { f32x4 v; v.x = acc[0][tm][4 * g]; v.y = acc[0][tm][4 * g + 1]; v.z = acc[0][tm][4 * g + 2]; v.w = acc[0][tm][4 * g + 3];
                        *(f32x4*)(LR + (size_t)m * 32 + 8 * g + 4 * hh) = v; } }
            }
        } else {
            int cls, sub;
            if (nb < 12) { cls = 0; sub = nb - 8; } else if (nb < 16) { cls = 1; sub = nb - 12; } else if (nb < 18) { cls = 2; sub = nb - 16; }
            else if (nb < 20) { cls = 3; sub = nb - 18; } else if (nb < 24) { cls = 4; sub = nb - 20; } else { cls = 5; sub = nb - 24; }
            const bool nat = (cls == 1 || cls == 5) ? lat : (cls == 2 || cls == 3), tr = (cls == 0 || cls == 3 || cls == 4);
            if (nat) {
#pragma unroll
                for (int tn = 0; tn < 4; ++tn)
#pragma unroll
                    for (int tm = 0; tm < 2; ++tm)
#pragma unroll
                        for (int g = 0; g < 4; ++g) { float v[4];
#pragma unroll
                            for (int e = 0; e < 4; ++e) { const float x = acc[tn][tm][4 * g + e]; v[e] = (cls == 1 || cls == 5) ? silu_fast(x) : (cls == 2 ? x * 0.125f : x); }
                            u32x2 p; p.x = pk2(v[0], v[1]); p.y = pk2(v[2], v[3]); put_nat(tn, tm, g, p); }
                flush_nat(cls == 1 ? RG : (cls == 5 ? GG : (cls == 2 ? GQ : GK)), (cls == 2 || cls == 3) ? 256 : 512, sub * 128);
            }
            if (tr) {
#pragma unroll
                for (int tn = 0; tn < 4; ++tn)
#pragma unroll
                    for (int tm = 0; tm < 2; ++tm)
#pragma unroll
                        for (int g = 0; g < 4; ++g) { u32x2 p; p.x = pk2(acc[tn][tm][4 * g], acc[tn][tm][4 * g + 1]); p.y = pk2(acc[tn][tm][4 * g + 2], acc[tn][tm][4 * g + 3]); put_tr(tn, tm, g, p); }
                flush_tr(cls == 0 ? RVT : (cls == 3 ? GKT : GVT), sub * 128);
            }
        }
        __syncthreads();
    }
};
struct EpiOut {
    const float* x; const float* mod; u16* out;
    __device__ __forceinline__ void operator()(f32x16 (&acc)[4][2], int mt, int nt, int wm, int wn, int l31, int hh, unsigned char*, int) const {
#pragma unroll
        for (int tn = 0; tn < 4; ++tn)
#pragma unroll
            for (int tm = 0; tm < 2; ++tm) { const int m = mt * 256 + wm * 64 + tm * 32 + l31; const float* g1 = mod + (m >> 13) * 6144 + 2 * 1024;
#pragma unroll
                for (int g = 0; g < 4; ++g) { const int n = nt * 256 + wn * 128 + tn * 32 + 8 * g + 4 * hh;
                    const f32x4 xv = *(const f32x4*)(x + (size_t)m * D + n), gv = *(const f32x4*)(g1 + n); f32x4 a; a.x = acc[tn][tm][4 * g]; a.y = acc[tn][tm][4 * g + 1]; a.z = acc[tn][tm][4 * g + 2]; a.w = acc[tn][tm][4 * g + 3];
                    const f32x4 o = xv + gv * a; u32x2 p; p.x = pk2(o.x, o.y); p.y = pk2(o.z, o.w); *(u32x2*)(out + (size_t)m * D + n) = p; } }
    }
};
__device__ __forceinline__ unsigned sortable(float x) { const unsigned u = __float_as_uint(x); return (u & 0x80000000u) ? ~u : (u | 0x80000000u); }
__device__ __forceinline__ float unsortable(unsigned s) { const unsigned u = (s & 0x80000000u) ? (s & 0x7fffffffu) : ~s; return __uint_as_float(u); }
#define TOPK_INSERT(t, v) do { unsigned _v = (v); _Pragma("unroll") for (int _s = 0; _s < 16; ++_s) { const unsigned _hi = max((t)[_s], _v); _v = min((t)[_s], _v); (t)[_s] = _hi; } } while (0)
#define CE_DESC(x, y) do { const unsigned hi_ = max((x), (y)), lo_ = min((x), (y)); (x) = hi_; (y) = lo_; } while (0)
__device__ __forceinline__ void bsort16(unsigned (&t)[16]) {
#pragma unroll
    for (int k = 2; k <= 16; k <<= 1)
#pragma unroll
        for (int j = k >> 1; j > 0; j >>= 1)
#pragma unroll
            for (int i = 0; i < 16; ++i) { const int l = i ^ j; if (l > i) { if ((i & k) == 0) CE_DESC(t[i], t[l]); else CE_DESC(t[l], t[i]); } }
}
__device__ __forceinline__ void bmerge16(unsigned (&a)[16], const unsigned (&b)[16]) {
#pragma unroll
    for (int i = 0; i < 16; ++i) a[i] = max(a[i], b[15 - i]);
#pragma unroll
    for (int j = 8; j > 0; j >>= 1)
#pragma unroll
        for (int i = 0; i < 16; ++i) { const int l = i ^ j; if (l > i) CE_DESC(a[i], a[l]); }
}
struct EpiQTopk {
    unsigned char* ws;
    __device__ __forceinline__ void operator()(f32x16 (&acc)[4][2], int mt, int nt, int wm_, int wn_, int l31_, int hh_, unsigned char* lds, int tid_) const {
        const int wm = opaque_i(wm_), wn = opaque_i(wn_), l31 = opaque_i(l31_), hh = opaque_i(hh_), tid = opaque_i(tid_);
        const int head = nt, half = wn;
        { const int lane_ = tid & 63; const u16* KG = (const u16*)(ws + (half ? OFF_K2 : OFF_K1)) + (size_t)head * 128 * 128;
            unsigned char* kl = lds + 65536 + half * 32768 + wm * 8192;
#pragma unroll 1
            for (int i_ = 0; i_ < 8; ++i_) { const int row = wm * 32 + i_ * 4 + (lane_ >> 4), c = (lane_ & 15) ^ (row & 15);
                __builtin_amdgcn_global_load_lds((const unsigned*)(KG + row * 128 + c * 8), (__attribute__((address_space(3))) unsigned*)(kl + i_ * 1024), 16, 0, 0); } }
        const unsigned char* KL = lds + 65536 + half * 32768;
        unsigned* LST = (unsigned*)lds;
        u16* IDX = (u16*)(ws + OFF_IDX); float* GW = (float*)(ws + OFF_GW);
        bf16x8 qf[2][8];
#pragma unroll
        for (int tm = 0; tm < 2; ++tm)
#pragma unroll
            for (int s8 = 0; s8 < 8; ++s8) { const int tn = s8 >> 1, r0 = 8 * (s8 & 1); u32x4 w;
                w.x = pk2(acc[tn][tm][r0 + 0], acc[tn][tm][r0 + 1]); w.y = pk2(acc[tn][tm][r0 + 2], acc[tn][tm][r0 + 3]); w.z = pk2(acc[tn][tm][r0 + 4], acc[tn][tm][r0 + 5]); w.w = pk2(acc[tn][tm][r0 + 6], acc[tn][tm][r0 + 7]);
                qf[tm][s8] = __builtin_bit_cast(bf16x8, w); }
        __builtin_amdgcn_sched_barrier(0);
        asm volatile("s_waitcnt vmcnt(0)" ::: "memory"); __syncthreads();
#pragma unroll
        for (int tm = 0; tm < 2; ++tm) {
            f32x16 sc[4];
#pragma unroll
            for (int kn = 0; kn < 4; ++kn)
#pragma unroll
                for (int r = 0; r < 16; ++r) sc[kn][r] = 0.f;
#pragma unroll
            for (int ks = 0; ks < 8; ++ks)
#pragma unroll
                for (int kn = 0; kn < 4; ++kn) { const bf16x8 a = *(const bf16x8*)(KL + off256(kn * 32 + l31, 2 * ks + hh)); sc[kn] = MFMA(a, qf[tm][ks], sc[kn]); }
            unsigned t[16], t1[16], t2[16], t3[16];
#pragma unroll
            for (int r = 0; r < 16; ++r) { const int nr = acc_row(r, hh);
                t[r] = (sortable(sc[0][r]) & 0xFFFFFF80u) | (unsigned)(127 - nr); t1[r] = (sortable(sc[1][r]) & 0xFFFFFF80u) | (unsigned)(127 - 32 - nr);
                t2[r] = (sortable(sc[2][r]) & 0xFFFFFF80u) | (unsigned)(127 - 64 - nr); t3[r] = (sortable(sc[3][r]) & 0xFFFFFF80u) | (unsigned)(127 - 96 - nr); }
            bsort16(t); bsort16(t1); bsort16(t2); bsort16(t3);
            bmerge16(t, t1); bmerge16(t2, t3); bmerge16(t, t2);
            unsigned pt[16];
#pragma unroll
            for (int s = 0; s < 16; ++s) pt[s] = (unsigned)__shfl_xor((int)t[s], 32);
            bmerge16(t, pt);
            if (hh == 0) {
                u32x4* dst = (u32x4*)(LST + ((wm * 64 + tm * 32 + l31) * 2 + half) * 16);
#pragma unroll
                for (int q = 0; q < 4; ++q) { u32x4 v; v.x = t[4 * q]; v.y = t[4 * q + 1]; v.z = t[4 * q + 2]; v.w = t[4 * q + 3]; dst[q] = v; }
            }
            __builtin_amdgcn_sched_barrier(0);
        }
        __syncthreads();
        if (tid < 256) {
            const int tok = tid; const int mm = mt * 256 + tok;
            unsigned la[16], lb[16];
#pragma unroll
            for (int q = 0; q < 4; ++q) { const u32x4 va = ((const u32x4*)(LST + (tok * 2) * 16))[q], vb = ((const u32x4*)(LST + (tok * 2 + 1) * 16))[q];
                la[4 * q] = va.x; la[4 * q + 1] = va.y; la[4 * q + 2] = va.z; la[4 * q + 3] = va.w; lb[4 * q] = vb.x; lb[4 * q + 1] = vb.y; lb[4 * q + 2] = vb.z; lb[4 * q + 3] = vb.w; }
            float va_[16], vb_[16];
#pragma unroll
            for (int s = 0; s < 16; ++s) { va_[s] = unsortable(la[s] & 0xFFFFFF80u); vb_[s] = unsortable(lb[s] & 0xFFFFFF80u); }
            unsigned t2[16];
#pragma unroll
            for (int s = 0; s < 16; ++s) t2[s] = 0u;
#pragma unroll
            for (int a = 0; a < 16; ++a)
#pragma unroll
                for (int b = 0; b < 16; ++b) if ((a + 1) * (b + 1) <= 16) { const unsigned key = (sortable(va_[a] + vb_[b]) & 0xFFFFFF00u) | (unsigned)(255 - (a * 16 + b)); TOPK_INSERT(t2, key); }
            float ts[16]; const float mx = unsortable(t2[0] & 0xFFFFFF00u); float sum = 0.f;
#pragma unroll
            for (int s = 0; s < 16; ++s) { ts[s] = __expf(unsortable(t2[s] & 0xFFFFFF00u) - mx); sum += ts[s]; }
            const float inv = 1.f / sum;
            int io[16];
#pragma unroll
            for (int s = 0; s < 16; ++s) { const int ab = 255 - (int)(t2[s] & 255u); const int a = ab >> 4, b = ab & 15;
                const int i1 = 127 - (int)(LST[(tok * 2) * 16 + a] & 127u), i2 = 127 - (int)(LST[(tok * 2 + 1) * 16 + b] & 127u); io[s] = i1 * 128 + i2; ts[s] *= inv; }
            u32x4* ip = (u32x4*)(IDX + (size_t)mm * 128 + head * 16); f32x4* gp = (f32x4*)(GW + (size_t)mm * 128 + head * 16);
#pragma unroll
            for (int q = 0; q < 2; ++q) { u32x4 v; v.x = (unsigned)io[8 * q] | ((unsigned)io[8 * q + 1] << 16); v.y = (unsigned)io[8 * q + 2] | ((unsigned)io[8 * q + 3] << 16); v.z = (unsigned)io[8 * q + 4] | ((unsigned)io[8 * q + 5] << 16); v.w = (unsigned)io[8 * q + 6] | ((unsigned)io[8 * q + 7] << 16); ip[q] = v; }
#pragma unroll
            for (int q = 0; q < 4; ++q) { f32x4 g; g.x = ts[4 * q]; g.y = ts[4 * q + 1]; g.z = ts[4 * q + 2]; g.w = ts[4 * q + 3]; gp[q] = g; }
        }
        __syncthreads();
    }
};

struct HookNone { __device__ __forceinline__ void issue(int, int) {} __device__ __forceinline__ void finish(int, int) {} };
struct HookDown {
    const float* src; unsigned char* dst; float* dsc; int gw, NGW, ln; f32x4 v[2][4];
    __device__ __forceinline__ void issue(int t, int nch) { const int per = 8 / nch;
#pragma unroll
        for (int u = 0; u < 2; ++u) if (u < per) { const float* p = src + (size_t)(gw + NGW * (t * per + u)) * 1024 + ln * 16;
#pragma unroll
            for (int q = 0; q < 4; ++q) v[u][q] = *(const f32x4*)(p + 4 * q); } }
    __device__ __forceinline__ void finish(int t, int nch) { const int per = 8 / nch;
#pragma unroll
        for (int u = 0; u < 2; ++u) if (u < per) { const int e = gw + NGW * (t * per + u); float mx = 0.f;
#pragma unroll
            for (int q = 0; q < 4; ++q) mx = fmaxf(mx, fmaxf(fmaxf(fabsf(v[u][q].x), fabsf(v[u][q].y)), fmaxf(fabsf(v[u][q].z), fabsf(v[u][q].w))));
            mx = fmaxf(wave_max(mx), 1e-30f); const float qsc = 127.f / mx; u32x4 o;
            o.x = q8x4(v[u][0].x, v[u][0].y, v[u][0].z, v[u][0].w, qsc); o.y = q8x4(v[u][1].x, v[u][1].y, v[u][1].z, v[u][1].w, qsc); o.z = q8x4(v[u][2].x, v[u][2].y, v[u][2].z, v[u][2].w, qsc); o.w = q8x4(v[u][3].x, v[u][3].y, v[u][3].z, v[u][3].w, qsc);
            *(u32x4*)(dst + (size_t)(ln >> 3) * 2097152 + (size_t)e * 128 + (size_t)(ln & 7) * 16) = o;
            if (ln == 0) dsc[e] = mx * (1.f / 127.f); } }
};
struct HookUp {
    const float* src; unsigned char* dst; int gt, NGT; f32x4 a[2][4];
    __device__ __forceinline__ void issue(int t, int nch) { const int per = 8 / nch;
#pragma unroll
        for (int u = 0; u < 2; ++u) if (u < per) { const float* p = src + (size_t)(gt + NGT * (t * per + u)) * 16;
#pragma unroll
            for (int q = 0; q < 4; ++q) a[u][q] = *(const f32x4*)(p + 4 * q); } }
    __device__ __forceinline__ void finish(int t, int nch) { const int per = 8 / nch;
#pragma unroll
        for (int u = 0; u < 2; ++u) if (u < per) { const int ch = gt + NGT * (t * per + u); u32x4 o; unsigned ow[4];
#pragma unroll
            for (int q = 0; q < 4; ++q) { int p = 0; p = __builtin_amdgcn_cvt_pk_fp8_f32(a[u][q].x * UP_SCALE, a[u][q].y * UP_SCALE, p, false); p = __builtin_amdgcn_cvt_pk_fp8_f32(a[u][q].z * UP_SCALE, a[u][q].w * UP_SCALE, p, true); ow[q] = (unsigned)p; }
            o.x = ow[0]; o.y = ow[1]; o.z = ow[2]; o.w = ow[3];
            *(u32x4*)(dst + (size_t)((ch & 63) >> 3) * 2097152 + (size_t)(ch >> 6) * 128 + (size_t)(ch & 7) * 16) = o; } }
};
constexpr int RS_Q = 0, RS_K = 16384, RS_KT = 32768, RS_VT = 49152, RS_P = 65536, RS_ST = 73728;
constexpr int GS_Q = 0, GS_K = 8192, GS_KT = 16384, GS_VT = 24576, GS_P = 40960, GS_ST = 49152, GS_LR = 65536, GS_SEG = 69632, GS_GL = 71680, GS_G = 71936;

template <int MODE, class Hook>
__device__ __forceinline__ void scan_ret2(const Args& A, unsigned char* lds, int gr, int k, int tid, Hook& hook) {
    const int lane = tid & 63, wave = tid >> 6, l31 = lane & 31, hh = lane >> 5;
    const int b = gr >> 3, h = (gr >> 1) & 3, dir = gr & 1;
    const u16* RQ = (const u16*)(A.ws + OFF_RQ); const u16* RK = (const u16*)(A.ws + OFF_RK); const u16* RKT = (const u16*)(A.ws + OFF_RKT); const u16* RVT = (const u16*)(A.ws + OFF_RVT);
    u16* OUT = (u16*)(A.ws + (dir ? OFF_ORB : OFF_ORF));
    const float lg = logsig_f(A.in[dir ? 10 : 9][h]); const float lg2c = lg * 1.4426950408889634f; float lg2 = lg2c;
    const float cd = __builtin_amdgcn_exp2f(lg2c * 64.f);
    const int nch = (k == 0) ? 4 : 8;
    const int dt = wave >> 1, wt0 = (wave & 1) * 2;
    f32x16 S[2];
    if (MODE == 1) {
        const float* slot = (const float*)(A.ws + OFF_SLOT_R) + (size_t)(gr * 16 + k - 1) * 16384;
#pragma unroll
        for (int q = 0; q < 2; ++q)
#pragma unroll
            for (int r = 0; r < 16; ++r) S[q][r] = slot[(dt * 32 + acc_row(r, hh)) * 128 + (wt0 + q) * 32 + l31];
    } else {
#pragma unroll
        for (int q = 0; q < 2; ++q)
#pragma unroll
            for (int r = 0; r < 16; ++r) S[q][r] = 0.f;
    }
    u32x4 rq[2], rk[2], rkt[2], rvt[2];
    auto tok0_of = [&](int t) -> int { if (k == 0) { const int cc = dir ? 3 - t : t; return T_LAT + b * CTXL + cc * 64; } const int sc = dir ? 16 - k : k - 1; const int c = sc * 8 + (dir ? 7 - t : t); return b * SEQ + c * 64; };
    auto issue = [&](int t) {
        const int tok0 = tok0_of(t);
#pragma unroll
        for (int e = 0; e < 2; ++e) { const int idx = tid + 512 * e;
            if (MODE == 1) { const int row = idx >> 4, ch = idx & 15; rq[e] = *(const u32x4*)(RQ + (size_t)(tok0 + row) * 512 + h * 128 + ch * 8); rk[e] = *(const u32x4*)(RK + (size_t)(tok0 + row) * 512 + h * 128 + ch * 8); }
            const int rowt = idx >> 3, cht = idx & 7; rkt[e] = *(const u32x4*)(RKT + (size_t)(h * 128 + rowt) * T_ALL + tok0 + cht * 8); rvt[e] = *(const u32x4*)(RVT + (size_t)(h * 128 + rowt) * T_ALL + tok0 + cht * 8); }
    };
    auto stage = [&]() {
#pragma unroll
        for (int e = 0; e < 2; ++e) { const int idx = tid + 512 * e;
            if (MODE == 1) { const int row = idx >> 4, ch = idx & 15; *(u32x4*)(lds + RS_Q + off256(row, ch)) = rq[e]; *(u32x4*)(lds + RS_K + off256(row, ch)) = rk[e]; }
            const int rowt = idx >> 3, cht = idx & 7; u32x4 v = rkt[e]; unsigned w[4] = {v.x, v.y, v.z, v.w};
#pragma unroll
            for (int q = 0; q < 4; ++q) { const int j = cht * 8 + 2 * q; const float e0 = dir ? (float)j : (float)(63 - j), e1 = dir ? (float)(j + 1) : (float)(62 - j);
                w[q] = pk2(bf_lo(w[q]) * __builtin_amdgcn_exp2f(lg2 * e0), bf_hi(w[q]) * __builtin_amdgcn_exp2f(lg2 * e1)); }
            v.x = w[0]; v.y = w[1]; v.z = w[2]; v.w = w[3];
            *(u32x4*)(lds + RS_KT + off128(rowt, cht)) = v; *(u32x4*)(lds + RS_VT + off128(rowt, cht)) = rvt[e]; }
    };
    auto put_st = [&]() {
#pragma unroll
        for (int q = 0; q < 2; ++q)
#pragma unroll
            for (int g = 0; g < 4; ++g) { u32x2 p; p.x = pk2(S[q][4 * g], S[q][4 * g + 1]); p.y = pk2(S[q][4 * g + 2], S[q][4 * g + 3]);
                *(u32x2*)(lds + RS_ST + off256((wt0 + q) * 32 + l31, dt * 4 + g) + hh * 8) = p; }
    };
    auto do_u = [&]() {
#pragma unroll
        for (int q = 0; q < 2; ++q)
#pragma unroll
            for (int r = 0; r < 16; ++r) S[q][r] *= cd;
#pragma unroll
        for (int ks = 0; ks < 4; ++ks) { const bf16x8 a = *(const bf16x8*)(lds + RS_KT + off128(dt * 32 + l31, 2 * ks + hh));
#pragma unroll
            for (int q = 0; q < 2; ++q) { const bf16x8 bv = *(const bf16x8*)(lds + RS_VT + off128((wt0 + q) * 32 + l31, 2 * ks + hh)); S[q] = MFMA(a, bv, S[q]); } }
    };
    issue(0);
    if (MODE == 1) put_st();
    for (int t = 0; t < nch; ++t) {
        const int tok0 = tok0_of(t);
        asm volatile("" : "+v"(lg2));
        stage();
        __syncthreads();
        if (t + 1 < nch) issue(t + 1);
        if (MODE == 0) { hook.issue(t, nch); do_u(); hook.finish(t, nch); __syncthreads(); continue; }
        if (wave < 4) {
            const int tj = wave >> 1, ti = wave & 1; f32x16 P;
#pragma unroll
            for (int r = 0; r < 16; ++r) P[r] = 0.f;
#pragma unroll
            for (int ks = 0; ks < 8; ++ks) { const bf16x8 a = *(const bf16x8*)(lds + RS_K + off256(tj * 32 + l31, 2 * ks + hh)); const bf16x8 bq = *(const bf16x8*)(lds + RS_Q + off256(ti * 32 + l31, 2 * ks + hh)); P = MFMA(a, bq, P); }
            const int i = ti * 32 + l31;
#pragma unroll
            for (int g = 0; g < 4; ++g) { float v[4];
#pragma unroll
                for (int e = 0; e < 4; ++e) { const int j = tj * 32 + 8 * g + 4 * hh + e; const int dlt = dir ? (j - i) : (i - j); v[e] = dlt >= 0 ? P[4 * g + e] * __builtin_amdgcn_exp2f(lg2 * (float)dlt) : 0.f; }
                u32x2 p; p.x = pk2(v[0], v[1]); p.y = pk2(v[2], v[3]);
                *(u32x2*)(lds + RS_P + off128(i, tj * 4 + g) + hh * 8) = p; }
        } else do_u();
        __syncthreads();
        {
            const int wt = wave >> 1, ti = wave & 1; f32x16 O;
#pragma unroll
            for (int r = 0; r < 16; ++r) O[r] = 0.f;
#pragma unroll
            for (int ks = 0; ks < 8; ++ks) { const bf16x8 a = *(const bf16x8*)(lds + RS_ST + off256(wt * 32 + l31, 2 * ks + hh)); const bf16x8 bq = *(const bf16x8*)(lds + RS_Q + off256(ti * 32 + l31, 2 * ks + hh)); O = MFMA(a, bq, O); }
            const int i = ti * 32 + l31; const float qd = __builtin_amdgcn_exp2f(lg2 * (dir ? (float)(64 - i) : (float)(i + 1)));
#pragma unroll
            for (int r = 0; r < 16; ++r) O[r] *= qd;
#pragma unroll
            for (int ks = 0; ks < 4; ++ks) { const bf16x8 a = *(const bf16x8*)(lds + RS_VT + off128(wt * 32 + l31, 2 * ks + hh)); const bf16x8 bp = *(const bf16x8*)(lds + RS_P + off128(ti * 32 + l31, 2 * ks + hh)); O = MFMA(a, bp, O); }
            u16* op = OUT + (size_t)(tok0 + i) * 512 + h * 128 + wt * 32;
#pragma unroll
            for (int g = 0; g < 4; ++g) { u32x2 p; p.x = pk2(O[4 * g], O[4 * g + 1]); p.y = pk2(O[4 * g + 2], O[4 * g + 3]); *(u32x2*)(op + 8 * g + 4 * hh) = p; }
        }
        if (wave < 4) do_u();
        __syncthreads();
        if (t + 1 < nch) put_st();
    }
    if (MODE == 0) {
        float* slot = (float*)(A.ws + OFF_SLOT_R) + (size_t)(gr * 16 + k) * 16384;
#pragma unroll
        for (int q = 0; q < 2; ++q)
#pragma unroll
            for (int r = 0; r < 16; ++r) slot[(dt * 32 + acc_row(r, hh)) * 128 + (wt0 + q) * 32 + l31] = S[q][r];
    }
}

template <int MODE, class Hook>
__device__ __forceinline__ void scan_gla2(const Args& A, unsigned char* lds, int gr, int k, int tid, Hook& hook) {
    const int lane = tid & 63, wave = tid >> 6, l31 = lane & 31, hh = lane >> 5;
    const int b = gr >> 3, h = (gr >> 1) & 3, dir = gr & 1;
    const u16* GQ = (const u16*)(A.ws + OFF_GQ); const u16* GK = (const u16*)(A.ws + OFF_GK); const u16* GKT = (const u16*)(A.ws + OFF_GKT); const u16* GVT = (const u16*)(A.ws + OFF_GVT);
    const float* LR = (const float*)(A.ws + OFF_LR);
    u16* OUT = (u16*)(A.ws + (dir ? OFF_OGB : OFF_OGF));
    const float* up = A.in[dir ? 13 : 11]; const float* bias = A.in[dir ? 14 : 12];
    const int dmy = tid & 63, seg = tid >> 6;
    float upr[16];
#pragma unroll
    for (int r = 0; r < 16; ++r) upr[r] = up[r * 256 + h * 64 + dmy];
    const float bs = bias[h * 64 + dmy];
    const int nch = (k == 0) ? 4 : 8;
    const int dt = wave >> 2, wt = wave & 3;
    f32x16 S;
    if (MODE == 1) {
        const float* slot = (const float*)(A.ws + OFF_SLOT_G) + (size_t)(gr * 16 + k - 1) * 8192;
#pragma unroll
        for (int r = 0; r < 16; ++r) S[r] = slot[(dt * 32 + acc_row(r, hh)) * 128 + wt * 32 + l31];
    } else {
#pragma unroll
        for (int r = 0; r < 16; ++r) S[r] = 0.f;
    }
    float gsum = 0.f;
    u32x4 rq, rk, rkt, rvt[2]; f32x4 rlr;
    auto tok0_of = [&](int t) -> int { if (k == 0) { const int cc = dir ? 3 - t : t; return T_LAT + b * CTXL + cc * 64; } const int sc = dir ? 16 - k : k - 1; const int c = sc * 8 + (dir ? 7 - t : t); return b * SEQ + c * 64; };
    auto issue = [&](int t) {
        const int tok0 = tok0_of(t); const int row = tid >> 3, ch = tid & 7;
        if (MODE == 1) { rq = *(const u32x4*)(GQ + (size_t)(tok0 + row) * 256 + h * 64 + ch * 8); rk = *(const u32x4*)(GK + (size_t)(tok0 + row) * 256 + h * 64 + ch * 8); }
        rkt = *(const u32x4*)(GKT + (size_t)(h * 64 + row) * T_ALL + tok0 + ch * 8);
#pragma unroll
        for (int e = 0; e < 2; ++e) rvt[e] = *(const u32x4*)(GVT + (size_t)(h * 128 + e * 64 + row) * T_ALL + tok0 + ch * 8);
        if (tid < 256) rlr = *(const f32x4*)(LR + (size_t)(tok0 + (tid >> 2)) * 32 + dir * 16 + (tid & 3) * 4);
    };
    auto put_st = [&]() {
#pragma unroll
        for (int g = 0; g < 4; ++g) { u32x2 p; p.x = pk2(S[4 * g], S[4 * g + 1]); p.y = pk2(S[4 * g + 2], S[4 * g + 3]);
            *(u32x2*)(lds + GS_ST + off128(wt * 32 + l31, dt * 4 + g) + hh * 8) = p; }
    };
    float* LRs = (float*)(lds + GS_LR); float* SEGs = (float*)(lds + GS_SEG); float* GLs = (float*)(lds + GS_GL); float* Gs = (float*)(lds + GS_G);
    auto do_u = [&]() {
#pragma unroll
        for (int r = 0; r < 16; ++r) S[r] *= __expf(GLs[dt * 32 + acc_row(r, hh)]);
#pragma unroll
        for (int ks = 0; ks < 4; ++ks) { const bf16x8 a = *(const bf16x8*)(lds + GS_KT + off128(dt * 32 + l31, 2 * ks + hh)); const bf16x8 bv = *(const bf16x8*)(lds + GS_VT + off128(wt * 32 + l31, 2 * ks + hh)); S = MFMA(a, bv, S); }
    };
    issue(0);
    if (MODE == 1) put_st();
    for (int t = 0; t < nch; ++t) {
        const int tok0 = tok0_of(t);
        if (tid < 256) *(f32x4*)(LRs + (tid >> 2) * 16 + (tid & 3) * 4) = rlr;
        __syncthreads();
        float pre[8];
#pragma unroll
        for (int e = 0; e < 8; ++e) { const float* lr = LRs + (seg * 8 + e) * 16; float a = bs;
#pragma unroll
            for (int r = 0; r < 16; ++r) a += lr[r] * upr[r];
            pre[e] = logsig_fast(a) * 0.0625f; }
        if (!dir) {
#pragma unroll
            for (int e = 1; e < 8; ++e) pre[e] += pre[e - 1];
            SEGs[seg * 64 + dmy] = pre[7];
        } else {
#pragma unroll
            for (int e = 6; e >= 0; --e) pre[e] += pre[e + 1];
            SEGs[seg * 64 + dmy] = pre[0];
        }
        __syncthreads();
        { float off = 0.f, tot = 0.f;
#pragma unroll
            for (int q = 0; q < 8; ++q) { const float v = SEGs[q * 64 + dmy]; tot += v; if (dir ? (q > seg) : (q < seg)) off += v; }
#pragma unroll
            for (int e = 0; e < 8; ++e) Gs[(seg * 8 + e) * 65 + dmy] = off + pre[e];
            if (seg == 0) { GLs[dmy] = tot; gsum += tot; } }
        __syncthreads();
        { const int row = tid >> 3, ch = tid & 7;
            if (MODE == 1) { unsigned w[4] = {rq.x, rq.y, rq.z, rq.w}; const float* g = Gs + row * 65 + ch * 8;
#pragma unroll
                for (int q = 0; q < 4; ++q) w[q] = pk2(bf_lo(w[q]) * __expf(g[2 * q]), bf_hi(w[q]) * __expf(g[2 * q + 1]));
                u32x4 v; v.x = w[0]; v.y = w[1]; v.z = w[2]; v.w = w[3]; *(u32x4*)(lds + GS_Q + off128(row, ch)) = v;
                unsigned wk[4] = {rk.x, rk.y, rk.z, rk.w};
#pragma unroll
                for (int q = 0; q < 4; ++q) wk[q] = pk2(bf_lo(wk[q]) * __expf(-g[2 * q]), bf_hi(wk[q]) * __expf(-g[2 * q + 1]));
                v.x = wk[0]; v.y = wk[1]; v.z = wk[2]; v.w = wk[3]; *(u32x4*)(lds + GS_K + off128(row, ch)) = v; }
            { unsigned w[4] = {rkt.x, rkt.y, rkt.z, rkt.w}; const float gl = GLs[row];
#pragma unroll
                for (int q = 0; q < 4; ++q) { const int j = ch * 8 + 2 * q; w[q] = pk2(bf_lo(w[q]) * __expf(gl - Gs[j * 65 + row]), bf_hi(w[q]) * __expf(gl - Gs[(j + 1) * 65 + row])); }
                u32x4 v; v.x = w[0]; v.y = w[1]; v.z = w[2]; v.w = w[3]; *(u32x4*)(lds + GS_KT + off128(row, ch)) = v; }
#pragma unroll
            for (int e = 0; e < 2; ++e) *(u32x4*)(lds + GS_VT + off128(e * 64 + row, ch)) = rvt[e];
        }
        __syncthreads();
        if (t + 1 < nch) issue(t + 1);
        if (MODE == 0) { hook.issue(t, nch); do_u(); hook.finish(t, nch); __syncthreads(); continue; }
        if (wave < 4) {
            const int tj = wave >> 1, ti = wave & 1; f32x16 P;
#pragma unroll
            for (int r = 0; r < 16; ++r) P[r] = 0.f;
#pragma unroll
            for (int ks = 0; ks < 4; ++ks) { const bf16x8 a = *(const bf16x8*)(lds + GS_K + off128(tj * 32 + l31, 2 * ks + hh)); const bf16x8 bq = *(const bf16x8*)(lds + GS_Q + off128(ti * 32 + l31, 2 * ks + hh)); P = MFMA(a, bq, P); }
            const int i = ti * 32 + l31;
#pragma unroll
            for (int g = 0; g < 4; ++g) { float v[4];
#pragma unroll
                for (int e = 0; e < 4; ++e) { const int j = tj * 32 + 8 * g + 4 * hh + e; const bool keep = dir ? (j >= i) : (i >= j); v[e] = keep ? P[4 * g + e] : 0.f; }
                u32x2 p; p.x = pk2(v[0], v[1]); p.y = pk2(v[2], v[3]);
                *(u32x2*)(lds + GS_P + off128(i, tj * 4 + g) + hh * 8) = p; }
        } else do_u();
        __syncthreads();
        {
            const int ot = wave >> 1, ti = wave & 1; f32x16 O;
#pragma unroll
            for (int r = 0; r < 16; ++r) O[r] = 0.f;
#pragma unroll
            for (int ks = 0; ks < 4; ++ks) { const bf16x8 a = *(const bf16x8*)(lds + GS_ST + off128(ot * 32 + l31, 2 * ks + hh)); const bf16x8 bq = *(const bf16x8*)(lds + GS_Q + off128(ti * 32 + l31, 2 * ks + hh)); O = MFMA(a, bq, O); }
#pragma unroll
            for (int ks = 0; ks < 4; ++ks) { const bf16x8 a = *(const bf16x8*)(lds + GS_VT + off128(ot * 32 + l31, 2 * ks + hh)); const bf16x8 bp = *(const bf16x8*)(lds + GS_P + off128(ti * 32 + l31, 2 * ks + hh)); O = MFMA(a, bp, O); }
            const int i = ti * 32 + l31;
            u16* op = OUT + (size_t)(tok0 + i) * 512 + h * 128 + ot * 32;
#pragma unroll
            for (int g = 0; g < 4; ++g) { u32x2 p; p.x = pk2(O[4 * g], O[4 * g + 1]); p.y = pk2(O[4 * g + 2], O[4 * g + 3]); *(u32x2*)(op + 8 * g + 4 * hh) = p; }
        }
        if (wave < 4) do_u();
        __syncthreads();
        if (t + 1 < nch) put_st();
    }
    if (MODE == 0) {
        float* slot = (float*)(A.ws + OFF_SLOT_G) + (size_t)(gr * 16 + k) * 8192;
#pragma unroll
        for (int r = 0; r < 16; ++r) slot[(dt * 32 + acc_row(r, hh)) * 128 + wt * 32 + l31] = S[r];
        if (tid < 64) ((float*)(A.ws + OFF_GSUM))[(gr * 16 + k) * 64 + tid] = gsum;
    }
}

__device__ __forceinline__ void scan_combine(const Args& A, int bid, int G, int tid) {
    const int gt = bid * NTHREADS + tid, NGT = G * NTHREADS;
    for (int i = gt; i < 16 * 4096 + 16 * 2048; i += NGT) {
        if (i < 16 * 4096) { const int gr = i >> 12, e4 = i & 4095; const int h = (gr >> 1) & 3, dir = gr & 1;
            const float dec = exp2f(logsig_f(A.in[dir ? 10 : 9][h]) * 1.4426950408889634f * 512.f);
            f32x4* base = (f32x4*)(A.ws + OFF_SLOT_R) + (size_t)gr * 16 * 4096 + e4; f32x4 run = base[0];
            for (int k = 2; k <= 16; ++k) { f32x4 v = base[(size_t)(k - 1) * 4096]; run = run * dec + v; base[(size_t)(k - 1) * 4096] = run; }
        } else { const int ii = i - 16 * 4096; const int gr = ii >> 11, e4 = ii & 2047; const int d = e4 >> 5;
            const float* gs = (const float*)(A.ws + OFF_GSUM) + gr * 16 * 64 + d;
            f32x4* base = (f32x4*)(A.ws + OFF_SLOT_G) + (size_t)gr * 16 * 2048 + e4; f32x4 run = base[0];
            for (int k = 2; k <= 16; ++k) { const float dec = __expf(gs[(k - 1) * 64]); f32x4 v = base[(size_t)(k - 1) * 2048]; run = run * dec + v; base[(size_t)(k - 1) * 2048] = run; }
        }
    }
}


__device__ __forceinline__ void phase4(const Args& A, int gw, int NGW, int lane) {
    u16* Y = (u16*)(A.ws + OFF_Y);
    const int niter_ = (NGW == 2048) ? 8 : (T_LAT + NGW - 1) / NGW;
    for (int i_ = 0; i_ < niter_; ++i_) { const int tok = xcd_row(i_, gw, NGW); if (tok >= T_LAT) break;
#pragma unroll
        for (int part = 0; part < 2; ++part) {
            const u16* OF = (const u16*)(A.ws + (part ? OFF_OGF : OFF_ORF)); const u16* OB = (const u16*)(A.ws + (part ? OFF_OGB : OFF_ORB)); const u16* GT = (const u16*)(A.ws + (part ? OFF_GG : OFF_RG));
            const u32x4 a = *(const u32x4*)(OF + (size_t)tok * 512 + lane * 8), b = *(const u32x4*)(OB + (size_t)tok * 512 + lane * 8), g = *(const u32x4*)(GT + (size_t)tok * 512 + lane * 8);
            const unsigned aw[4] = {a.x, a.y, a.z, a.w}, bw[4] = {b.x, b.y, b.z, b.w}, gw4[4] = {g.x, g.y, g.z, g.w};
            float o[8]; float ss = 0.f;
#pragma unroll
            for (int q = 0; q < 4; ++q) { o[2 * q] = bf_lo(aw[q]) + bf_lo(bw[q]); o[2 * q + 1] = bf_hi(aw[q]) + bf_hi(bw[q]); ss += o[2 * q] * o[2 * q] + o[2 * q + 1] * o[2 * q + 1]; }
            ss += __shfl_xor(ss, 1); ss += __shfl_xor(ss, 2); ss += __shfl_xor(ss, 4); ss += __shfl_xor(ss, 8);
            const float rs = 1.f / sqrtf(ss * (1.f / 128.f) + 1e-6f);
            u32x4 y; unsigned yw[4];
#pragma unroll
            for (int q = 0; q < 4; ++q) yw[q] = pk2(o[2 * q] * rs * bf_lo(gw4[q]), o[2 * q + 1] * rs * bf_hi(gw4[q]));
            y.x = yw[0]; y.y = yw[1]; y.z = yw[2]; y.w = yw[3];
            *(u32x4*)(Y + (size_t)tok * PITCH + part * 512 + lane * 8) = y;
        }
    }
}

__device__ __forceinline__ float dpp_sum8(float v) {
    v += __builtin_bit_cast(float, __builtin_amdgcn_update_dpp(0, __builtin_bit_cast(int, v), 0xB1, 0xF, 0xF, true));
    v += __builtin_bit_cast(float, __builtin_amdgcn_update_dpp(0, __builtin_bit_cast(int, v), 0x4E, 0xF, 0xF, true));
    v += __builtin_bit_cast(float, __builtin_amdgcn_update_dpp(0, __builtin_bit_cast(int, v), 0x141, 0xF, 0xF, true));
    return v;
}
__device__ __forceinline__ int dpp_isum8(int v) {
    v += __builtin_amdgcn_update_dpp(0, v, 0xB1, 0xF, 0xF, true);
    v += __builtin_amdgcn_update_dpp(0, v, 0x4E, 0xF, 0xF, true);
    v += __builtin_amdgcn_update_dpp(0, v, 0x141, 0xF, 0xF, true);
    return v;
}
__device__ __forceinline__ void gather_down(const Args& A, int bid, int G, int wave, int lane) {
    const unsigned char* H2Q = A.ws + OFF_H2Q; const u16* IDX = (const u16*)(A.ws + OFF_IDX);
    const int x = bid & 7, nwx = (G >> 3) * NWAVES, wv = (bid >> 3) * NWAVES + wave;
    const unsigned char* DNS = (const unsigned char*)A.out + DOUT_DOWN + (size_t)x * 2097152 + (lane & 7) * 16;
    u16* PART = (u16*)(A.ws + OFF_PART) + (size_t)x * T_LAT * 128;
    const int r = lane >> 3;
    constexpr int U = 2;
    u32x4 ei[U][2], hq[U];
#pragma unroll
    for (int u = 0; u < U; ++u) { const int t0 = wv + u * nwx; const u32x4* ip0 = (const u32x4*)(IDX + (size_t)t0 * 128 + r * 16); ei[u][0] = ip0[0]; ei[u][1] = ip0[1];
        hq[u] = *(const u32x4*)(H2Q + (size_t)t0 * 1024 + x * 128 + (lane & 7) * 16); }
    for (int tok = wv; tok < T_LAT; tok += U * nwx) {
        u32x4 rows[U][16]; u32x4 hr[U];
#pragma unroll
        for (int u = 0; u < U; ++u) { const unsigned ew[8] = {ei[u][0].x, ei[u][0].y, ei[u][0].z, ei[u][0].w, ei[u][1].x, ei[u][1].y, ei[u][1].z, ei[u][1].w};
#pragma unroll
            for (int it = 0; it < 16; ++it) { const unsigned e = (it & 1) ? (ew[it >> 1] >> 16) : (ew[it >> 1] & 0xffffu); rows[u][it] = *(const u32x4*)(DNS + (size_t)e * 128); }
            hr[u] = hq[u]; }
#pragma unroll
        for (int u = 0; u < U; ++u) { const int tn = tok + (U + u) * nwx < T_LAT ? tok + (U + u) * nwx : tok; const u32x4* ipn = (const u32x4*)(IDX + (size_t)tn * 128 + r * 16); ei[u][0] = ipn[0]; ei[u][1] = ipn[1];
            hq[u] = *(const u32x4*)(H2Q + (size_t)tn * 1024 + x * 128 + (lane & 7) * 16); }
#pragma unroll
        for (int u = 0; u < U; ++u) { int res[16];
#pragma unroll
            for (int it = 0; it < 16; ++it) { int a = 0;
                a = __builtin_amdgcn_sdot4((int)rows[u][it].x, (int)hr[u].x, a, false); a = __builtin_amdgcn_sdot4((int)rows[u][it].y, (int)hr[u].y, a, false);
                a = __builtin_amdgcn_sdot4((int)rows[u][it].z, (int)hr[u].z, a, false); a = __builtin_amdgcn_sdot4((int)rows[u][it].w, (int)hr[u].w, a, false);
                res[it] = dpp_isum8(a); }
            if ((lane & 7) == 0) { u32x4* pp = (u32x4*)(PART + (size_t)(tok + u * nwx) * 128 + r * 16);
#pragma unroll
                for (int q = 0; q < 2; ++q) { u32x4 v; v.x = pkh2((float)res[8 * q] * 0.015625f, (float)res[8 * q + 1] * 0.015625f); v.y = pkh2((float)res[8 * q + 2] * 0.015625f, (float)res[8 * q + 3] * 0.015625f);
                    v.z = pkh2((float)res[8 * q + 4] * 0.015625f, (float)res[8 * q + 5] * 0.015625f); v.w = pkh2((float)res[8 * q + 6] * 0.015625f, (float)res[8 * q + 7] * 0.015625f); pp[q] = v; } } }
    }
}
__device__ __forceinline__ void gather_coef(const Args& A, int bid, int G, int tid) {
    const u16* PART = (const u16*)(A.ws + OFF_PART); const float* GWt = (const float*)(A.ws + OFF_GW); u16* COEF = (u16*)(A.ws + OFF_COEF);
    const u16* IDX = (const u16*)(A.ws + OFF_IDX); const float* HS = (const float*)(A.ws + OFF_HS); const float* DSC = (const float*)((const unsigned char*)A.out + DOUT_DSC);
    typedef int i32x4 __attribute__((ext_vector_type(4)));
    const int gt = bid * NTHREADS + tid, NGT = G * NTHREADS;
    for (int i = gt; i < T_LAT * 32; i += NGT) {
        f32x4 s = {0.f, 0.f, 0.f, 0.f}; u32x2 pv[8];
#pragma unroll
        for (int xs = 0; xs < 8; ++xs) pv[xs] = *(const u32x2*)(PART + (size_t)xs * T_LAT * 128 + (size_t)i * 4);
#pragma unroll
        for (int xs = 0; xs < 8; ++xs) { const f32x2 lo = unpkh2(pv[xs].x), hi = unpkh2(pv[xs].y); s.x += lo.x; s.y += lo.y; s.z += hi.x; s.w += hi.y; }
        s = s * 64.f;
        const f32x4 g = *(const f32x4*)(GWt + (size_t)i * 4); const u32x2 ew = *(const u32x2*)(IDX + (size_t)i * 4); const float hs = HS[i >> 5]; f32x4 o;
        { const float v = s.x * hs * DSC[ew.x & 0xffffu]; o.x = 0.5f * v * (1.f + erff(v * 0.70710678118654752f)) * g.x * (1.f / UP_SCALE); }
        { const float v = s.y * hs * DSC[ew.x >> 16];     o.y = 0.5f * v * (1.f + erff(v * 0.70710678118654752f)) * g.y * (1.f / UP_SCALE); }
        { const float v = s.z * hs * DSC[ew.y & 0xffffu]; o.z = 0.5f * v * (1.f + erff(v * 0.70710678118654752f)) * g.z * (1.f / UP_SCALE); }
        { const float v = s.w * hs * DSC[ew.y >> 16];     o.w = 0.5f * v * (1.f + erff(v * 0.70710678118654752f)) * g.w * (1.f / UP_SCALE); }
        u32x2 p; p.x = pk2(o.x, o.y); p.y = pk2(o.z, o.w); *(u32x2*)(COEF + (size_t)i * 4) = p;
    }
}
__device__ __forceinline__ void gather_up(const Args& A, int bid, int G, int wave, int lane) {
    const u16* IDX = (const u16*)(A.ws + OFF_IDX); const u16* COEF = (const u16*)(A.ws + OFF_COEF); float* SSQ = (float*)(A.ws + OFF_SSQ);
    const float* mod = (const float*)(A.ws + OFF_MOD); u16* out = (u16*)(A.ws + OFF_X1);
    const int x = bid & 7, nwx = (G >> 3) * NWAVES, wv = (bid >> 3) * NWAVES + wave;
    const unsigned char* UPS = (const unsigned char*)A.out + DOUT_UP + (size_t)x * 2097152 + (lane & 7) * 16;
    const int r = lane >> 3, col = x * 128 + (lane & 7) * 16 + 2 * r;
    const int nu = T_LAT / nwx;
    struct RS { u32x4 rows[16]; u32x4 cw[2]; f32x2 gv; unsigned x1v; };
    RS SA, SB; u32x4 eiA[2], eiB[2];
    auto ld_idx = [&](int n, u32x4 (&ei)[2]) { const int t = wv + (n < nu ? n : nu - 1) * nwx; const u32x4* ip = (const u32x4*)(IDX + (size_t)t * 128 + r * 16); ei[0] = ip[0]; ei[1] = ip[1]; };
    auto ld_rows = [&](int n, const u32x4 (&ei)[2], RS& rs) { const int t = wv + (n < nu ? n : nu - 1) * nwx;
        const unsigned ew[8] = {ei[0].x, ei[0].y, ei[0].z, ei[0].w, ei[1].x, ei[1].y, ei[1].z, ei[1].w};
#pragma unroll
        for (int it = 0; it < 16; ++it) { const unsigned e = (it & 1) ? (ew[it >> 1] >> 16) : (ew[it >> 1] & 0xffffu); rs.rows[it] = *(const u32x4*)(UPS + (size_t)e * 128); }
        const u32x4* cp = (const u32x4*)(COEF + (size_t)t * 128 + r * 16); rs.cw[0] = cp[0]; rs.cw[1] = cp[1];
        rs.gv = *(const f32x2*)(mod + (t >> 13) * 6144 + 5 * 1024 + col); rs.x1v = *(const unsigned*)(out + (size_t)t * D + col); };
    auto compute = [&](int n, const RS& rs) { const int t = wv + n * nwx;
        f32x2 acc[8];
#pragma unroll
        for (int q = 0; q < 8; ++q) { acc[q].x = 0.f; acc[q].y = 0.f; }
        const unsigned cww[8] = {rs.cw[0].x, rs.cw[0].y, rs.cw[0].z, rs.cw[0].w, rs.cw[1].x, rs.cw[1].y, rs.cw[1].z, rs.cw[1].w};
#pragma unroll
        for (int it = 0; it < 16; ++it) { const float ck = (it & 1) ? bf_hi(cww[it >> 1]) : bf_lo(cww[it >> 1]); f32x2 ck2; ck2.x = ck; ck2.y = ck; const unsigned w[4] = {rs.rows[it].x, rs.rows[it].y, rs.rows[it].z, rs.rows[it].w};
#pragma unroll
            for (int q = 0; q < 4; ++q) { const f32x2 lo = __builtin_amdgcn_cvt_pk_f32_fp8((int)w[q], false), hi = __builtin_amdgcn_cvt_pk_f32_fp8((int)w[q], true);
                acc[2 * q] = __builtin_elementwise_fma(ck2, lo, acc[2 * q]); acc[2 * q + 1] = __builtin_elementwise_fma(ck2, hi, acc[2 * q + 1]); } }
        f32x2 a4[4], a2[2], a1;
        { const bool hi = (lane & 32) != 0;
#pragma unroll
            for (int q = 0; q < 4; ++q) { const f32x2 send = hi ? acc[q] : acc[q + 4], keep = hi ? acc[q + 4] : acc[q]; f32x2 recv; recv.x = __shfl_xor(send.x, 32); recv.y = __shfl_xor(send.y, 32); a4[q] = keep + recv; } }
        { const bool hi = (lane & 16) != 0;
#pragma unroll
            for (int q = 0; q < 2; ++q) { const f32x2 send = hi ? a4[q] : a4[q + 2], keep = hi ? a4[q + 2] : a4[q]; f32x2 recv; recv.x = __shfl_xor(send.x, 16); recv.y = __shfl_xor(send.y, 16); a2[q] = keep + recv; } }
        { const bool hi = (lane & 8) != 0; const f32x2 send = hi ? a2[0] : a2[1], keep = hi ? a2[1] : a2[0]; f32x2 recv; recv.x = __shfl_xor(send.x, 8); recv.y = __shfl_xor(send.y, 8); a1 = keep + recv; }
        f32x2 x1f; x1f.x = bf_lo(rs.x1v); x1f.y = bf_hi(rs.x1v); const f32x2 x2f = x1f + rs.gv * a1; const unsigned pk = pk2(x2f.x, x2f.y); *(unsigned*)(out + (size_t)t * D + col) = pk;
        f32x2 x2; x2.x = bf_lo(pk); x2.y = bf_hi(pk);
        const float ss = wave_sum(x2.x * x2.x + x2.y * x2.y);
        if (lane == 0) SSQ[(size_t)t * 8 + x] = ss; };
    ld_idx(0, eiA); ld_idx(1, eiB);
    ld_rows(0, eiA, SA); ld_rows(1, eiB, SB);
    ld_idx(2, eiA); ld_idx(3, eiB);
    for (int n = 0; n < nu; n += 2) {
        compute(n, SA);
        ld_rows(n + 2, eiA, SA); ld_idx(n + 4, eiA);
        compute(n + 1, SB);
        ld_rows(n + 3, eiB, SB); ld_idx(n + 5, eiB);
    }
}
__device__ __forceinline__ void final_norm(const Args& A, int gw, int NGW, int lane) {
    const float* SSQ = (const float*)(A.ws + OFF_SSQ); const float* nfw = A.in[21]; const u16* x2 = (const u16*)(A.ws + OFF_X1); float* out = A.out;
    f32x4 wv[4], s0, s1; u32x2 x[4];
    { const f32x4* w4 = (const f32x4*)nfw + lane;
#pragma unroll
      for (int j = 0; j < 4; ++j) wv[j] = w4[64 * j]; }
    { const int tok = gw < T_LAT ? gw : T_LAT - 1; s0 = *(const f32x4*)(SSQ + (size_t)tok * 8); s1 = *(const f32x4*)(SSQ + (size_t)tok * 8 + 4); const u32x2* i4 = (const u32x2*)(x2 + (size_t)tok * D) + lane;
#pragma unroll
      for (int j = 0; j < 4; ++j) x[j] = i4[64 * j]; }
    for (int tok = gw; tok < T_LAT; tok += NGW) {
        const int tn = tok + NGW < T_LAT ? tok + NGW : tok; u32x2 xn[4];
        const f32x4 n0 = *(const f32x4*)(SSQ + (size_t)tn * 8), n1 = *(const f32x4*)(SSQ + (size_t)tn * 8 + 4); const u32x2* i4 = (const u32x2*)(x2 + (size_t)tn * D) + lane;
#pragma unroll
        for (int j = 0; j < 4; ++j) xn[j] = i4[64 * j];
        const float ss = ((s0.x + s0.y) + (s0.z + s0.w)) + ((s1.x + s1.y) + (s1.z + s1.w));
        const float rstd = 1.f / sqrtf(ss * (1.f / D) + 1e-6f);
        f32x4* o4 = (f32x4*)(out + (size_t)tok * D) + lane;
#pragma unroll
        for (int j = 0; j < 4; ++j) { f32x4 xf; xf.x = bf_lo(x[j].x); xf.y = bf_hi(x[j].x); xf.z = bf_lo(x[j].y); xf.w = bf_hi(x[j].y); o4[64 * j] = xf * rstd * wv[j]; }
#pragma unroll
        for (int j = 0; j < 4; ++j) x[j] = xn[j];
        s0 = n0; s1 = n1;
    }
}

__global__ void __launch_bounds__(NTHREADS) fwd_kernel(Args A) {
    extern __shared__ __attribute__((aligned(16))) unsigned char lds[];
    const int wave = __builtin_amdgcn_readfirstlane((int)threadIdx.x >> 6), bid = blockIdx.x, G = gridDim.x;
#define lane lane_id_asm()
#define tid (wave * 64 + lane)
    const int gw = bid * NWAVES + wave, NGW = G * NWAVES;
    const int lo = A.ph_lo, hi = A.ph_hi;
#if !N_LAUNCH_SPLIT
    volatile unsigned* bst = (volatile unsigned*)(lds + LDS_BYTES - 16);
    if (tid == 0) { bst[0] = 0u; bst[1] = 0u; }
    __syncthreads();
    XcdBarrier bar = xcd_barrier_post((unsigned*)(A.ws + OFF_CTL), bst);
#define GRID_BAR() xcd_barrier(bar)
#else
#define GRID_BAR() do {} while (0)
#endif
#define IN(k) (lo <= (k) && (k) < hi)
#define SEAM(k) do { if (IN(k) && IN((k) + 1)) GRID_BAR(); } while (0)
    const float* mod = (const float*)(A.ws + OFF_MOD);
#define OT(x) opaque_i(x)
    if (IN(0)) { phase0(A, lds, bid, G, OT(tid)); __syncthreads(); }
    if (IN(1)) norm_rows<false, false>(A.in[0], A.in[2], T_ALL, A.in[6], mod, 0, 1, (u16*)(A.ws + OFF_H), OT(gw), NGW, OT(lane), nullptr, nullptr, (unsigned*)(A.ws + OFF_CTL));
    SEAM(1);
    if (IN(2)) { EpiIn e{A.ws}; gemm_phase((const u16*)(A.ws + OFF_H), (const u16*)(A.ws + OFF_WIN), T_ALL / 256, NIN_PAD / 256, lds, e, bid, G, OT(tid)); }
    SEAM(2);
    if (IN(3)) {
        HookDown hd{A.in[19], (unsigned char*)A.out + DOUT_DOWN, (float*)((unsigned char*)A.out + DOUT_DSC), gw, NGW, OT(lane)};
        HookUp hu{A.in[20], (unsigned char*)A.out + DOUT_UP, bid * NTHREADS + OT(tid), G * NTHREADS};
        scan_ret2<0>(A, lds, bid >> 4, bid & 15, OT(tid), hd); __syncthreads(); scan_gla2<0>(A, lds, bid >> 4, bid & 15, OT(tid), hu); }
    SEAM(3);
    if (IN(4)) scan_combine(A, bid, G, OT(tid));
    SEAM(4);
    if (IN(5)) { HookNone hn; scan_ret2<1>(A, lds, bid >> 4, (bid & 15) + 1, OT(tid), hn); __syncthreads(); scan_gla2<1>(A, lds, bid >> 4, (bid & 15) + 1, OT(tid), hn); }
    SEAM(5);
    if (IN(6)) phase4(A, OT(gw), NGW, OT(lane));
    SEAM(6);
    if (IN(7)) { EpiOut e{A.in[0], mod, (u16*)(A.ws + OFF_X1)}; gemm_phase((const u16*)(A.ws + OFF_Y), (const u16*)(A.ws + OFF_WOUT), T_LAT / 256, 1024 / 256, lds, e, bid, G, OT(tid)); }
    SEAM(7);
    if (IN(8)) {
        norm_rows<true, true>((const float*)(A.ws + OFF_X1), nullptr, T_LAT, A.in[7], mod, 3, 4, (u16*)(A.ws + OFF_H2), OT(gw), NGW, OT(lane), A.ws + OFF_H2Q, (float*)(A.ws + OFF_HS));
    }
    SEAM(8);
    if (IN(9)) { EpiQTopk e{A.ws}; gemm_phase((const u16*)(A.ws + OFF_H2), (const u16*)(A.ws + OFF_WQ), T_LAT / 256, 2048 / 256, lds, e, bid, G, OT(tid)); }
    SEAM(9);
    if (IN(10)) gather_down(A, bid, G, wave, OT(lane));
    SEAM(10);
    if (IN(11)) gather_coef(A, bid, G, OT(tid));
    SEAM(11);
    if (IN(12)) gather_up(A, bid, G, wave, OT(lane));
    SEAM(12);
    if (IN(13)) final_norm(A, OT(gw), NGW, OT(lane));
#undef lane
#undef tid
}

extern "C" void kernel_launch(void* const* d_in, const int* in_sizes, int n_in, void* d_out, int out_size, void* d_ws, size_t ws_size, hipStream_t stream) {
    static int grid = 0;
    if (grid == 0) {
        if (n_in != 22 || out_size != T_LAT * D || ws_size < WS_NEED) { fprintf(stderr, "kernel_launch: unexpected shapes (n_in %d out %d ws %zu need %zu)\n", n_in, out_size, ws_size, (size_t)WS_NEED); grid = -1; return; }
        int dev = 0, cus = 0;
        if (hipGetDevice(&dev) != hipSuccess || hipDeviceGetAttribute(&cus, hipDeviceAttributeMultiprocessorCount, dev) != hipSuccess) { grid = -1; return; }
        if (hipFuncSetAttribute((const void*)fwd_kernel, hipFuncAttributeMaxDynamicSharedMemorySize, LDS_BYTES) != hipSuccess) { fprintf(stderr, "kernel_launch: hipFuncSetAttribute failed\n"); grid = -1; return; }
        int per_cu = 0;
        if (hipOccupancyMaxActiveBlocksPerMultiprocessor(&per_cu, (const void*)fwd_kernel, NTHREADS, LDS_BYTES) != hipSuccess || per_cu < 1) { fprintf(stderr, "kernel_launch: occupancy query says %d\n", per_cu); }
        (void)hipGetLastError();
        if (cus < 256) fprintf(stderr, "kernel_launch: %d CUs reported; this kernel is built for 256 (one 512-thread workgroup per CU)\n", cus);
        grid = 256;
    }
    if (grid < 0) return;
    (void)hipMemsetAsync((char*)d_ws + OFF_CTL, 0, CTL_BYTES, stream);
    Args a{};
    for (int i = 0; i < 22; ++i) a.in[i] = (const float*)d_in[i];
    a.out = (float*)d_out; a.ws = (unsigned char*)d_ws; a.rep = 0;
#if N_LAUNCH_SPLIT
    for (int p = 0; p < NPHASES; ++p) { a.ph_lo = p; a.ph_hi = p + 1; hipLaunchKernelGGL(fwd_kernel, dim3(grid), dim3(NTHREADS), LDS_BYTES, stream, a); }
#else
    a.ph_lo = 0; a.ph_hi = NPHASES;
    hipLaunchKernelGGL(fwd_kernel, dim3(grid), dim3(NTHREADS), LDS_BYTES, stream, a);
#endif
}
```

```cpp
#include <hip/hip_runtime.h>
#include <cstdio>
#include <cstdint>

typedef short bf16x8 __attribute__((ext_vector_type(8)));
typedef float f32x16 __attribute__((ext_vector_type(16)));
typedef float f32x4 __attribute__((ext_vector_type(4)));
typedef float f32x2 __attribute__((ext_vector_type(2)));
typedef unsigned u32x4 __attribute__((ext_vector_type(4)));
typedef unsigned u32x2 __attribute__((ext_vector_type(2)));
typedef unsigned short u16;

#ifndef N_LAUNCH_SPLIT
#define N_LAUNCH_SPLIT 0
#endif

constexpr int D = 1024, NBATCH = 2, SEQ = 8192, CTXL = 256;
constexpr int T_LAT = NBATCH * SEQ;
constexpr int T_ALL = T_LAT + NBATCH * CTXL;
constexpr int NIN = 3616, NIN_PAD = 3840;
constexpr int PITCH = 1088;
constexpr int NTHREADS = 512, NWAVES = 8;
constexpr int LDS_BYTES = 132 * 1024;
constexpr int NPHASES = 14;

constexpr size_t OFF_CTL = 0;
constexpr size_t CTL_BYTES = 16 * 1024;
constexpr size_t OFF_MOD = 64 * 1024;
constexpr size_t OFF_TABR = 192 * 1024;
constexpr size_t OFF_TABC = 224 * 1024;
constexpr size_t OFF_WIN = 256 * 1024;
constexpr size_t OFF_WOUT = OFF_WIN + (size_t)NIN_PAD * PITCH * 2;
constexpr size_t OFF_WQ = OFF_WOUT + (size_t)1024 * PITCH * 2;
constexpr size_t OFF_K1 = OFF_WQ + (size_t)2048 * PITCH * 2;
constexpr size_t OFF_K2 = OFF_K1 + (size_t)8 * 128 * 128 * 2;
constexpr size_t OFF_FEAT = OFF_K2 + (size_t)8 * 128 * 128 * 2;
constexpr size_t PL512 = (size_t)T_ALL * 512 * 2, PL256 = (size_t)T_ALL * 256 * 2;
constexpr size_t OFF_RQ = OFF_FEAT, OFF_RK = OFF_RQ + PL512, OFF_RKT = OFF_RK + PL512, OFF_RVT = OFF_RKT + PL512, OFF_RG = OFF_RVT + PL512;
constexpr size_t OFF_GQ = OFF_RG + PL512, OFF_GK = OFF_GQ + PL256, OFF_GKT = OFF_GK + PL256, OFF_GVT = OFF_GKT + PL256, OFF_GG = OFF_GVT + PL512;
constexpr size_t OFF_LR = OFF_GG + PL512;
constexpr size_t OFF_O = OFF_LR + (size_t)T_ALL * 32 * 4;
constexpr size_t OPL = (size_t)T_LAT * 512 * 2;
constexpr size_t OFF_ORF = OFF_O, OFF_ORB = OFF_ORF + OPL, OFF_OGF = OFF_ORB + OPL, OFF_OGB = OFF_OGF + OPL;
constexpr size_t OFF_H = OFF_O;
constexpr size_t OFF_Y = OFF_RQ;
constexpr size_t OFF_SLOT_R = OFF_OGB + OPL;
constexpr size_t OFF_SLOT_G = OFF_SLOT_R + (size_t)16 * 16 * 65536;
constexpr size_t OFF_GSUM = OFF_SLOT_G + (size_t)16 * 16 * 32768;
constexpr size_t WS_END_A = OFF_GSUM + 65536;
constexpr size_t OFF_H2 = OFF_FEAT;
constexpr size_t OFF_QB = OFF_H2 + (size_t)T_LAT * PITCH * 2;
constexpr size_t OFF_IDX = OFF_QB;
constexpr size_t OFF_GW = OFF_IDX + (size_t)T_LAT * 128 * 4;
constexpr size_t OFF_X1 = OFF_GW + (size_t)T_LAT * 128 * 4;
constexpr size_t OFF_UPB = OFF_X1 + (size_t)16384 * 1024 * 2;
constexpr size_t DOUT_DOWN = 0, DOUT_UP = (size_t)16384 * 1024, DOUT_DSC = (size_t)2 * 16384 * 1024;
constexpr size_t OFF_COEF = OFF_UPB + (size_t)16384 * 1024 * 2;
constexpr size_t OFF_SSQ = OFF_COEF + (size_t)T_LAT * 128 * 4;
constexpr size_t OFF_PART = OFF_SSQ + (size_t)T_LAT * 8 * 4;
constexpr size_t OFF_H2Q = OFF_PART + (size_t)8 * T_LAT * 128 * 2;
constexpr size_t OFF_HS = OFF_H2Q + (size_t)T_LAT * 1024;
constexpr size_t OFF_DSC = OFF_HS + (size_t)T_LAT * 4;
constexpr size_t WS_END_B = OFF_DSC + (size_t)16384 * 4;
constexpr size_t WS_NEED = WS_END_A > WS_END_B ? WS_END_A : WS_END_B;
static_assert(WS_NEED <= (size_t)256 * 1024 * 1024, "workspace map exceeds the guaranteed 256 MiB");
static_assert((size_t)T_ALL * PITCH * 2 <= 4 * OPL && (size_t)T_LAT * PITCH * 2 <= 3 * PL512, "H / Y aliases");

constexpr float UP_SCALE = 64.f;
__device__ const double ROPE_INV[32] = {1.0, 0.7498942093324559, 0.5623413251903491, 0.4216965034285822, 0.31622776601683794, 0.23713737056616552, 0.1778279410038923, 0.1333521432163324, 0.1, 0.07498942093324558, 0.05623413251903491, 0.042169650342858224, 0.03162277660168379, 0.023713737056616554, 0.01778279410038923, 0.01333521432163324, 0.01, 0.007498942093324558, 0.005623413251903491, 0.004216965034285823, 0.0031622776601683794, 0.0023713737056616554, 0.0017782794100389228, 0.001333521432163324, 0.001, 0.0007498942093324559, 0.0005623413251903491, 0.00042169650342858224, 0.00031622776601683794, 0.00023713737056616554, 0.00017782794100389227, 0.0001333521432163324};

struct Args { const float* in[22]; float* out; unsigned char* ws; int ph_lo, ph_hi; int rep, pad; };

__device__ __forceinline__ int lane_id_asm() { int x; asm volatile("v_mbcnt_lo_u32_b32 %0, -1, 0\n\tv_mbcnt_hi_u32_b32 %0, -1, %0" : "=v"(x)); return x; }
__device__ __forceinline__ int opaque_i(int x) { asm volatile("" : "+v"(x)); return x; }
typedef __bf16 bf16x2_t __attribute__((ext_vector_type(2)));
__device__ __forceinline__ unsigned pk2(float lo, float hi) { f32x2 f; f.x = lo; f.y = hi; const bf16x2_t v = __builtin_convertvector(f, bf16x2_t); return __builtin_bit_cast(unsigned, v); }
typedef _Float16 f16x2_t __attribute__((ext_vector_type(2)));
__device__ __forceinline__ unsigned pkh2(float a, float b) { f32x2 v; v.x = a; v.y = b; const f16x2_t h = __builtin_convertvector(v, f16x2_t); return __builtin_bit_cast(unsigned, h); }
__device__ __forceinline__ f32x2 unpkh2(unsigned u) { const f16x2_t h = __builtin_bit_cast(f16x2_t, u); return __builtin_convertvector(h, f32x2); }
__device__ __forceinline__ float bf_lo(unsigned u) { return __uint_as_float(u << 16); }
__device__ __forceinline__ float bf_hi(unsigned u) { return __uint_as_float(u & 0xffff0000u); }
__device__ __forceinline__ u16 bf1(float x) { return (u16)(pk2(x, 0.f) & 0xffffu); }
#define DPPF_(v_, ctrl_) __uint_as_float(__builtin_amdgcn_update_dpp(0u, __float_as_uint(v_), ctrl_, 0xF, 0xF, true))
__device__ __forceinline__ float wave_max(float v) {
    v = fmaxf(v, DPPF_(v, 0xB1)); v = fmaxf(v, DPPF_(v, 0x4E)); v = fmaxf(v, DPPF_(v, 0x141)); v = fmaxf(v, DPPF_(v, 0x140));
    { const auto r = __builtin_amdgcn_permlane16_swap(__float_as_uint(v), __float_as_uint(v), false, false); v = fmaxf(__uint_as_float(r[0]), __uint_as_float(r[1])); }
    { const auto r = __builtin_amdgcn_permlane32_swap(__float_as_uint(v), __float_as_uint(v), false, false); v = fmaxf(__uint_as_float(r[0]), __uint_as_float(r[1])); }
    return v;
}
__device__ __forceinline__ unsigned q8x4(float a, float b, float c, float d, float sc) {
    const int ia = (int)rintf(a * sc), ib = (int)rintf(b * sc), ic = (int)rintf(c * sc), id = (int)rintf(d * sc);
    return ((unsigned)ia & 0xffu) | (((unsigned)ib & 0xffu) << 8) | (((unsigned)ic & 0xffu) << 16) | ((unsigned)id << 24);
}
__device__ __forceinline__ float row16_sum(float v) { v += DPPF_(v, 0xB1); v += DPPF_(v, 0x4E); v += DPPF_(v, 0x141); v += DPPF_(v, 0x140); return v; }
__device__ __forceinline__ float wave_sum(float v) {
    v = row16_sum(v);
    { const auto r = __builtin_amdgcn_permlane16_swap(__float_as_uint(v), __float_as_uint(v), false, false); v = __uint_as_float(r[0]) + __uint_as_float(r[1]); }
    { const auto r = __builtin_amdgcn_permlane32_swap(__float_as_uint(v), __float_as_uint(v), false, false); v = __uint_as_float(r[0]) + __uint_as_float(r[1]); }
    return v;
}
__device__ __forceinline__ float silu_f(float x) { return x / (1.f + expf(-x)); }
__device__ __forceinline__ float logsig_f(float x) { return fminf(x, 0.f) - log1pf(expf(-fabsf(x))); }
__device__ __forceinline__ float logsig_fast(float x) { return fminf(x, 0.f) - __logf(1.f + __expf(-fabsf(x))); }
__device__ __forceinline__ float silu_fast(float x) { return x * __builtin_amdgcn_rcpf(1.f + __expf(-x)); }
#define MFMA(a, b, c) __builtin_amdgcn_mfma_f32_32x32x16_bf16((a), (b), (c), 0, 0, 0)
__device__ __forceinline__ int acc_row(int r, int hh) { return (r & 3) + 8 * (r >> 2) + 4 * hh; }

__device__ __forceinline__ int off128(int r, int c) { return r * 128 + ((c ^ ((r >> 1) & 7)) << 4); }
__device__ __forceinline__ int off256(int r, int c) { return r * 256 + ((c ^ (r & 15)) << 4); }

#define XB_TMO      128
#define XB_XCNT(j)  (256  + 64 * (j))
#define XB_XSUB(j)  (1280 + 64 * (j))
#define XB_XGEN(j)  (2304 + 64 * (j))
#define XB_TOP      3328
#define XB_TOPGEN   3392
#define XCD_BAR_WORDS 3456
#define XB_MODCNT   3520
#define XB_SPIN_CAP (1u << 22)
__device__ __forceinline__ unsigned xb_ld(unsigned* p)              { return __hip_atomic_load(p, __ATOMIC_RELAXED, __HIP_MEMORY_SCOPE_AGENT); }
__device__ __forceinline__ unsigned xb_add(unsigned* p, unsigned v) { return __hip_atomic_fetch_add(p, v, __ATOMIC_RELAXED, __HIP_MEMORY_SCOPE_AGENT); }
__device__ __forceinline__ unsigned xb_xcc_id() { return (unsigned)__builtin_amdgcn_s_getreg((3 << 11) | 20) & 0xFu; }
#define XB_SPIN(cond, bar) do { unsigned _sp = 0; while (cond) { __builtin_amdgcn_s_sleep(1); \
    if ((++_sp & 255u) == 0u) { if (xb_ld(&(bar)[XB_TMO])) break; if (_sp > XB_SPIN_CAP) { atomicAdd(&(bar)[XB_TMO], 1u); break; } } } } while (0)
struct XcdBarrier { unsigned* bar; unsigned x; volatile unsigned* st; };
__device__ __forceinline__ XcdBarrier xcd_barrier_post(unsigned* bar, volatile unsigned* st) {
    XcdBarrier b; b.bar = bar; b.x = xb_xcc_id(); b.st = st;
    if (threadIdx.x == 0) (void)xb_add(&bar[XB_XCNT(b.x)], 1u);
    return b;
}
__device__ __forceinline__ void xcd_barrier_complete(unsigned* bar, unsigned x, unsigned& nloc, unsigned& nx) {
    const unsigned G = gridDim.x * gridDim.y * gridDim.z;
    unsigned sum, cnt, mine, sp = 0u;
    for (;;) {
        sum = 0u; cnt = 0u; mine = 0u;
#pragma unroll
        for (unsigned j = 0; j < 16; ++j) { const unsigned c = xb_ld(&bar[XB_XCNT(j)]); sum += c; cnt += (c > 0u) ? 1u : 0u; mine = (j == x) ? c : mine; }
        if (sum == G) break;
        __builtin_amdgcn_s_sleep(1);
        if ((++sp & 255u) == 0u) { if (xb_ld(&bar[XB_TMO])) break; if (sp > XB_SPIN_CAP) { atomicAdd(&bar[XB_TMO], 1u); break; } }
    }
    nloc = mine > 0u ? mine : 1u; nx = cnt > 0u ? cnt : 1u;
}
__device__ __forceinline__ void xcd_barrier(const XcdBarrier& b) {
    asm volatile("s_waitcnt vmcnt(0)" ::: "memory");
    __syncthreads();
    if (threadIdx.x == 0) {
        unsigned* bar = b.bar;
        __builtin_amdgcn_s_waitcnt(0);
        unsigned nloc = b.st[0], nx = b.st[1];
        if (nloc == 0u) { xcd_barrier_complete(bar, b.x, nloc, nx); b.st[0] = nloc; b.st[1] = nx; }
        const unsigned old = xb_add(&bar[XB_XSUB(b.x)], 1u);
        const unsigned gen = old / nloc;
        if (old + 1u == (gen + 1u) * nloc) {
            __builtin_amdgcn_fence(__ATOMIC_RELEASE, "agent");
            asm volatile("s_waitcnt vmcnt(0)" ::: "memory");
            const unsigned og = xb_add(&bar[XB_TOP], 1u);
            if (og + 1u != (gen + 1u) * nx) XB_SPIN(xb_ld(&bar[XB_TOP]) < (gen + 1u) * nx, bar);
            __builtin_amdgcn_fence(__ATOMIC_ACQUIRE, "agent");
        } else {
            XB_SPIN(xb_ld(&bar[XB_TOP]) < (gen + 1u) * nx, bar);
            __builtin_amdgcn_fence(__ATOMIC_ACQUIRE, "agent");
            asm volatile("s_waitcnt vmcnt(0)" ::: "memory");
        }
    }
    __syncthreads();
}

constexpr int NGEMV = 192;
__device__ __forceinline__ void transpose_item64(const float* W, int N, int nvalid, int n0, u16* WT, int k0, int lane) {
    const int n = n0 + lane; const bool ok = n < nvalid; const int nl = ok ? n : 0;
    float v[64];
#pragma unroll
    for (int i = 0; i < 64; ++i) { const float* rowp = W + (size_t)(k0 + i) * N; v[i] = rowp[nl]; }
    u32x4* o = (u32x4*)(WT + (size_t)n * PITCH + k0);
#pragma unroll
    for (int j = 0; j < 8; ++j) { u32x4 q; q.x = pk2(v[8 * j], v[8 * j + 1]); q.y = pk2(v[8 * j + 2], v[8 * j + 3]); q.z = pk2(v[8 * j + 4], v[8 * j + 5]); q.w = pk2(v[8 * j + 6], v[8 * j + 7]);
        if (!ok) { q.x = 0u; q.y = 0u; q.z = 0u; q.w = 0u; }
        o[j] = q; }
}
__device__ __forceinline__ void sincos_d(double a, float& c, float& s) {
    const double TWO_PI = 6.283185307179586476925287;
    a -= rint(a / TWO_PI) * TWO_PI;
    const double x2 = a * a;
    double sc = 1.0, ss = 1.0;
#pragma unroll
    for (int k = 15; k >= 1; --k) { sc = 1.0 - sc * x2 / (double)((2 * k - 1) * (2 * k)); ss = 1.0 - ss * x2 / (double)((2 * k) * (2 * k + 1)); }
    c = (float)sc; s = (float)(ss * a);
}
__device__ __forceinline__ void phase0(const Args& A, unsigned char* lds, int bid, int G, int tid) {
    const int lane = tid & 63, wave = tid >> 6;
    const float* c = A.in[1]; const float* c_ctx = A.in[3]; const float* w_mod = A.in[4]; const float* b_mod = A.in[5];
    float* mod = (float*)(A.ws + OFF_MOD);
    if (bid < NGEMV) {
        float* sv = (float*)lds;
        float* red = sv + 3072;
        for (int i = tid; i < 3072; i += NTHREADS) { const int v = i >> 10, k = i & 1023; const float x = (v < 2) ? c[v * 1024 + k] : c_ctx[k]; sv[i] = silu_f(x); }
        const int c0 = bid * 32, kr = lane >> 3, cq = (lane & 7) * 4;
        const float* wp = w_mod + (size_t)(wave * 128 + kr) * 6144 + c0 + cq;
        f32x4 wv[16];
#pragma unroll
        for (int i = 0; i < 16; ++i) wv[i] = *(const f32x4*)(wp + (size_t)(8 * i) * 6144);
        __syncthreads();
        f32x4 a0 = {0.f, 0.f, 0.f, 0.f}, a1 = a0, a2 = a0;
#pragma unroll
        for (int i = 0; i < 16; ++i) { const int kk = wave * 128 + 8 * i + kr; a0 += wv[i] * sv[kk]; a1 += wv[i] * sv[1024 + kk]; a2 += wv[i] * sv[2048 + kk]; }
#pragma unroll
        for (int m = 8; m < 64; m <<= 1) {
            a0.x += __shfl_xor(a0.x, m); a0.y += __shfl_xor(a0.y, m); a0.z += __shfl_xor(a0.z, m); a0.w += __shfl_xor(a0.w, m);
            a1.x += __shfl_xor(a1.x, m); a1.y += __shfl_xor(a1.y, m); a1.z += __shfl_xor(a1.z, m); a1.w += __shfl_xor(a1.w, m);
            a2.x += __shfl_xor(a2.x, m); a2.y += __shfl_xor(a2.y, m); a2.z += __shfl_xor(a2.z, m); a2.w += __shfl_xor(a2.w, m); }
        if (lane < 8) { *(f32x4*)(red + (wave * 3 + 0) * 32 + cq) = a0; *(f32x4*)(red + (wave * 3 + 1) * 32 + cq) = a1; *(f32x4*)(red + (wave * 3 + 2) * 32 + cq) = a2; }
        __syncthreads();
        if (tid < 96) { const int v = tid >> 5, l = tid & 31; float sacc = b_mod[c0 + l];
#pragma unroll
            for (int w = 0; w < 8; ++w) sacc += red[(w * 3 + v) * 32 + l];
            mod[v * 6144 + c0 + l] = sacc; }
        asm volatile("s_waitcnt vmcnt(0)" ::: "memory"); __syncthreads();
        if (tid == 0) { __builtin_amdgcn_fence(__ATOMIC_RELEASE, "agent"); (void)xb_add((unsigned*)(A.ws + OFF_CTL) + XB_MODCNT, 1u); }
    }
    {
        const int vb = bid >= NGEMV ? bid - NGEMV : bid + (G - NGEMV);
        constexpr int I_IN = 16 * (NIN_PAD / 64), I_OUT = 16 * 16, I_Q = 16 * 32;
        u16* win_t = (u16*)(A.ws + OFF_WIN); u16* wout_t = (u16*)(A.ws + OFF_WOUT); u16* wq_t = (u16*)(A.ws + OFF_WQ);
        for (int it = vb * NWAVES + wave; it < I_IN + I_OUT + I_Q; it += G * NWAVES) {
            int r = it;
            if (r < I_IN) { transpose_item64(A.in[8], NIN, NIN, (r % (NIN_PAD / 64)) * 64, win_t, (r / (NIN_PAD / 64)) * 64, lane); continue; }
            r -= I_IN;
            if (r < I_OUT) { transpose_item64(A.in[15], 1024, 1024, (r % 16) * 64, wout_t, (r / 16) * 64, lane); continue; }
            r -= I_OUT;
            transpose_item64(A.in[16], 2048, 2048, (r % 32) * 64, wq_t, (r / 32) * 64, lane);
        }
        const int gt = vb * NTHREADS + tid, NGT = G * NTHREADS;
        for (int i = gt; i < 2 * 16384; i += NGT) { const int which = i >> 14, ch = i & 16383; const int hh_ = ch & 1; const float* src = A.in[17 + which] + (size_t)(ch >> 1) * 16 + 4 * hh_;
            const f32x4 a = *(const f32x4*)src, b = *(const f32x4*)(src + 8); u32x4 o; o.x = pk2(a.x, a.y); o.y = pk2(a.z, a.w); o.z = pk2(b.x, b.y); o.w = pk2(b.z, b.w);
            *(u32x4*)(A.ws + (which ? OFF_K2 : OFF_K1) + (size_t)ch * 16) = o; }
        for (int i = gt - 64 * NTHREADS; i >= 0 && i < 192 * 32; i += NGT) { const int p = i >> 5, f = i & 31; float cs, sn; const int pos = p < 128 ? p : p - 128; sincos_d((double)pos * ROPE_INV[f], cs, sn);
            f32x2* t = (f32x2*)(A.ws + (p < 128 ? OFF_TABR : OFF_TABC)) + pos * 32 + f; f32x2 v; v.x = cs; v.y = sn; *t = v; }
    }
}

__device__ __forceinline__ int xcd_row(int i, int gw, int NGW) {
    const int bid = gw >> 3, wave = gw & 7, x = bid & 7, wl = (bid >> 3) * 8 + wave;
    const int ra = 2048 * x + wl + 256 * i, rb = 16384 + gw + 2048 * (i - 8), rc = gw + i * NGW;
    return (NGW == 2048) ? (i < 8 ? ra : rb) : rc;
}
template <bool Q8, bool BFIN>
__device__ __forceinline__ void norm_rows(const float* src_lat, const float* src_ctx, int nrows, const float* w, const float* mod, int shift_idx, int scale_idx, u16* dst, int gw, int NGW, int lane, unsigned char* q8 = nullptr, float* qs = nullptr, unsigned* ctl = nullptr) {
    const int niter_ = (NGW == 2048) ? (nrows > 16384 ? 9 : 8) : (nrows + NGW - 1) / NGW;
    f32x4 x[4], mul[4], shf[4]; u32x4 xb[2]; int vcur = -1;
    int r = xcd_row(0, gw, NGW);
    { const int rc = r < nrows ? r : nrows - 1;
      if (BFIN) { const u32x4* s8 = (const u32x4*)((const u16*)src_lat + (size_t)rc * D) + lane;
#pragma unroll
          for (int j = 0; j < 2; ++j) xb[j] = s8[64 * j]; }
      else { const f32x4* s4 = (const f32x4*)(rc < T_LAT ? src_lat + (size_t)rc * D : src_ctx + (size_t)(rc - T_LAT) * D) + 2 * lane;
#pragma unroll
          for (int j = 0; j < 4; ++j) x[j] = s4[128 * (j >> 1) + (j & 1)]; } }
    for (int i_ = 0; i_ < niter_; ++i_) {
        const int rn = i_ + 1 < niter_ ? xcd_row(i_ + 1, gw, NGW) : nrows; f32x4 xn[4]; u32x4 xbn[2];
        { const int rc = rn < nrows ? rn : nrows - 1;
          if (BFIN) { const u32x4* s8 = (const u32x4*)((const u16*)src_lat + (size_t)rc * D) + lane;
#pragma unroll
              for (int j = 0; j < 2; ++j) xbn[j] = s8[64 * j]; }
          else { const f32x4* s4 = (const f32x4*)(rc < T_LAT ? src_lat + (size_t)rc * D : src_ctx + (size_t)(rc - T_LAT) * D) + 2 * lane;
#pragma unroll
              for (int j = 0; j < 4; ++j) xn[j] = s4[128 * (j >> 1) + (j & 1)]; } }
        if (BFIN) {
#pragma unroll
            for (int j = 0; j < 2; ++j) { x[2 * j].x = bf_lo(xb[j].x); x[2 * j].y = bf_hi(xb[j].x); x[2 * j].z = bf_lo(xb[j].y); x[2 * j].w = bf_hi(xb[j].y);
                x[2 * j + 1].x = bf_lo(xb[j].z); x[2 * j + 1].y = bf_hi(xb[j].z); x[2 * j + 1].z = bf_lo(xb[j].w); x[2 * j + 1].w = bf_hi(xb[j].w); } }
        if (r < nrows) {
            const int v = r < T_LAT ? (r >> 13) : 2;
            if (v != vcur) {
                if (ctl != nullptr && vcur < 0) { if (threadIdx.x == 0) { XB_SPIN(xb_ld(&ctl[XB_MODCNT]) < (unsigned)NGEMV, ctl); __builtin_amdgcn_fence(__ATOMIC_ACQUIRE, "agent"); } __syncthreads(); }
                vcur = v; const f32x4* w4 = (const f32x4*)w + 2 * lane; const f32x4* sh4 = (const f32x4*)(mod + v * 6144 + shift_idx * 1024) + 2 * lane; const f32x4* sc4 = (const f32x4*)(mod + v * 6144 + scale_idx * 1024) + 2 * lane;
#pragma unroll
                for (int j = 0; j < 4; ++j) { const int o_ = 128 * (j >> 1) + (j & 1); mul[j] = w4[o_] * (sc4[o_] + 1.f); shf[j] = sh4[o_]; } }
            float ss = 0.f;
#pragma unroll
            for (int j = 0; j < 4; ++j) ss += (x[j].x * x[j].x + x[j].y * x[j].y) + (x[j].z * x[j].z + x[j].w * x[j].w);
            const float rstd = 1.f / sqrtf(wave_sum(ss) * (1.f / D) + 1e-6f);
            u32x4* o = (u32x4*)(dst + (size_t)r * PITCH) + lane; f32x4 y[4]; float mx = 0.f;
#pragma unroll
            for (int j = 0; j < 4; ++j) { y[j] = x[j] * rstd * mul[j] + shf[j];
                if (Q8) mx = fmaxf(mx, fmaxf(fmaxf(fabsf(y[j].x), fabsf(y[j].y)), fmaxf(fabsf(y[j].z), fabsf(y[j].w)))); }
#pragma unroll
            for (int j = 0; j < 2; ++j) { u32x4 p; p.x = pk2(y[2 * j].x, y[2 * j].y); p.y = pk2(y[2 * j].z, y[2 * j].w); p.z = pk2(y[2 * j + 1].x, y[2 * j + 1].y); p.w = pk2(y[2 * j + 1].z, y[2 * j + 1].w); o[64 * j] = p; }
            if (Q8) {
                mx = fmaxf(wave_max(mx), 1e-20f); const float qsc = 127.f / mx; u32x2* qo = (u32x2*)(q8 + (size_t)r * D) + lane;
#pragma unroll
                for (int j = 0; j < 2; ++j) { u32x2 q; q.x = q8x4(y[2 * j].x, y[2 * j].y, y[2 * j].z, y[2 * j].w, qsc); q.y = q8x4(y[2 * j + 1].x, y[2 * j + 1].y, y[2 * j + 1].z, y[2 * j + 1].w, qsc); qo[64 * j] = q; }
                if (lane == 0) qs[r] = mx * (1.f / 127.f); }
        }
#pragma unroll
        for (int j = 0; j < 4; ++j) { if (!BFIN) x[j] = xn[j]; }
#pragma unroll
        for (int j = 0; j < 2; ++j) { if (BFIN) xb[j] = xbn[j]; }
        r = rn;
    }
}

#define RAW_BARRIER() do { __builtin_amdgcn_s_waitcnt(0xC07F)  ; asm volatile("" ::: "memory"); __builtin_amdgcn_s_barrier(); asm volatile("" ::: "memory"); } while (0)
template <class Epi>
__device__ __forceinline__ void gemm_phase(const u16* Ag_, const u16* Bg_, int Mtiles, int Ntiles, unsigned char* lds, const Epi& epi, int bid, int G, int tid) {
    const int lane = tid & 63, wave = __builtin_amdgcn_readfirstlane(tid >> 6), wm = wave >> 1, wn = wave & 1, l31 = lane & 31, hh = lane >> 5;
    const bool xo = (G == 256); const int xcd = bid & 7, jx = bid >> 3, mper = Mtiles >> 3, nmain = xo ? mper * Ntiles : Mtiles * Ntiles, nextra = xo ? (Mtiles - mper * 8) * Ntiles : 0;
    const int srow = wave * 32 + (lane >> 2), sc = ((lane & 3) ^ ((lane >> 4) & 3)) * 8;
    const int fsw = (l31 >> 2) & 3;
    const int koff = xo ? (((jx & 7) + (jx >> 3)) & 3) : 0;
    for (int q = xo ? jx : bid; q < nmain + ((nextra + 7) >> 3); q += xo ? 32 : G) {
        int mt, nt;
        if (!xo) { mt = q / Ntiles; nt = q % Ntiles; }
        else if (q < nmain) { mt = xcd * mper + q % mper; nt = q / mper; }
        else { const int e = (q - nmain) * 8 + xcd; if (e >= nextra) continue; mt = mper * 8 + e / Ntiles; nt = e % Ntiles; }
        const int so_ = opaque_i(srow * PITCH + sc);
        const u16* Ag = Ag_ + (size_t)mt * (256 * PITCH) + so_; const u16* Bg = Bg_ + (size_t)nt * (256 * PITCH) + so_;
        f32x16 acc[4][2];
#pragma unroll
        for (int i = 0; i < 4; ++i)
#pragma unroll
            for (int j = 0; j < 2; ++j)
#pragma unroll
                for (int r = 0; r < 16; ++r) acc[i][j][r] = 0.f;
        asm volatile("s_waitcnt vmcnt(0)" ::: "memory");
#define GEMM_ISSUE(kt_) do { unsigned char* st_ = lds + ((kt_) & 3) * 32768 + wave * 2048; \
        __builtin_amdgcn_global_load_lds((const unsigned*)(Ag + (((kt_) + koff) & 31) * 32), (__attribute__((address_space(3))) unsigned*)(st_), 16, 0, 0); \
        __builtin_amdgcn_global_load_lds((const unsigned*)(Ag + (((kt_) + koff) & 31) * 32 + 16 * PITCH), (__attribute__((address_space(3))) unsigned*)(st_ + 1024), 16, 0, 0); \
        __builtin_amdgcn_global_load_lds((const unsigned*)(Bg + (((kt_) + koff) & 31) * 32), (__attribute__((address_space(3))) unsigned*)(st_ + 16384), 16, 0, 0); \
        __builtin_amdgcn_global_load_lds((const unsigned*)(Bg + (((kt_) + koff) & 31) * 32 + 16 * PITCH), (__attribute__((address_space(3))) unsigned*)(st_ + 16384 + 1024), 16, 0, 0); } while (0)
        GEMM_ISSUE(0); GEMM_ISSUE(1); GEMM_ISSUE(2);
#define GEMM_LOADF(F_, kt_, ks_) do { const unsigned char* Ac_ = lds + ((kt_) & 3) * 32768; const unsigned char* Bc_ = Ac_ + 16384; const int co_ = ((((ks_) * 2 + hh) ^ fsw) << 4); \
        _Pragma("unroll") for (int tm = 0; tm < 2; ++tm) F_##a[tm] = *(const bf16x8*)(Ac_ + (wm * 64 + tm * 32 + l31) * 64 + co_); \
        _Pragma("unroll") for (int tn = 0; tn < 4; ++tn) F_##b[tn] = *(const bf16x8*)(Bc_ + (wn * 128 + tn * 32 + l31) * 64 + co_); } while (0)
#define GEMM_MFMA(F_) do { _Pragma("unroll") for (int tn = 0; tn < 4; ++tn) _Pragma("unroll") for (int tm = 0; tm < 2; ++tm) acc[tn][tm] = MFMA(F_##b[tn], F_##a[tm], acc[tn][tm]); } while (0)
        bf16x8 F0a[2], F0b[4], F1a[2], F1b[4], F2a[2], F2b[4];
        asm volatile("s_waitcnt vmcnt(8)" ::: "memory"); RAW_BARRIER();
        GEMM_LOADF(F0, 0, 0);
#define LDA_(F_, tm_, kt_, ks_) F_##a[tm_] = *(const bf16x8*)(lds + ((kt_) & 3) * 32768 + (wm * 64 + (tm_) * 32 + l31) * 64 + ((((ks_) * 2 + hh) ^ fsw) << 4))
#define LDB_(F_, tn_, kt_, ks_) F_##b[tn_] = *(const bf16x8*)(lds + ((kt_) & 3) * 32768 + 16384 + (wn * 128 + (tn_) * 32 + l31) * 64 + ((((ks_) * 2 + hh) ^ fsw) << 4))
#define MF_(F_, tn_, tm_) acc[tn_][tm_] = MFMA(F_##b[tn_], F_##a[tm_], acc[tn_][tm_])
#define SB_() __builtin_amdgcn_sched_barrier(0)
#define GEMM_STEP(CUR, NXT, kt_) do { \
            if ((kt_) < 31) { if ((kt_) < 30) asm volatile("s_waitcnt vmcnt(4)" ::: "memory"); else asm volatile("s_waitcnt vmcnt(0)" ::: "memory"); \
                RAW_BARRIER(); if ((kt_) + 3 < 32 && wave < 4) GEMM_ISSUE((kt_) + 3); if ((kt_) == 30) epi.prefetch(lds, nt, wm, wn, tid); } \
            SB_(); LDA_(F1, 0, kt_, 1); LDB_(F1, 0, kt_, 1); SB_(); MF_(CUR, 0, 0); SB_(); \
            LDA_(F1, 1, kt_, 1); LDB_(F1, 1, kt_, 1); SB_(); MF_(CUR, 0, 1); SB_(); \
            LDB_(F1, 2, kt_, 1); LDB_(F1, 3, kt_, 1); SB_(); MF_(CUR, 1, 0); SB_(); \
            if ((kt_) < 31) { LDA_(NXT, 0, (kt_) + 1, 0); LDB_(NXT, 0, (kt_) + 1, 0); } SB_(); MF_(CUR, 1, 1); SB_(); \
            if ((kt_) < 31) { LDA_(NXT, 1, (kt_) + 1, 0); LDB_(NXT, 1, (kt_) + 1, 0); } SB_(); MF_(CUR, 2, 0); SB_(); \
            if ((kt_) < 31) { LDB_(NXT, 2, (kt_) + 1, 0); LDB_(NXT, 3, (kt_) + 1, 0); } SB_(); MF_(CUR, 2, 1); MF_(CUR, 3, 0); MF_(CUR, 3, 1); SB_(); \
            MF_(F1, 0, 0); MF_(F1, 0, 1); MF_(F1, 1, 0); MF_(F1, 1, 1); SB_(); \
            if ((kt_) + 3 < 32 && wave >= 4) GEMM_ISSUE((kt_) + 3); SB_(); \
            MF_(F1, 2, 0); MF_(F1, 2, 1); MF_(F1, 3, 0); MF_(F1, 3, 1); SB_(); } while (0)
        for (int kt = 0; kt < 32; kt += 2) { GEMM_STEP(F0, F2, kt); GEMM_STEP(F2, F0, kt + 1); }
        __syncthreads();
        epi(acc, mt, nt, wm, wn, l31, hh, lds, tid);
    }
}

struct EpiIn {
    __device__ __forceinline__ void prefetch(unsigned char*, int, int, int, int) const {}
    unsigned char* ws;
    __device__ __forceinline__ void operator()(f32x16 (&acc)[4][2], int mt, int nt, int wm_, int wn_, int l31_, int hh_, unsigned char* lds, int tid_) const {
        const int wm = opaque_i(wm_), wn = opaque_i(wn_), l31 = opaque_i(l31_), hh = opaque_i(hh_), tid = opaque_i(tid_);
        u16* RQ = (u16*)(ws + OFF_RQ); u16* RK = (u16*)(ws + OFF_RK); u16* RKT = (u16*)(ws + OFF_RKT); u16* RVT = (u16*)(ws + OFF_RVT); u16* RG = (u16*)(ws + OFF_RG);
        u16* GQ = (u16*)(ws + OFF_GQ); u16* GK = (u16*)(ws + OFF_GK); u16* GKT = (u16*)(ws + OFF_GKT); u16* GVT = (u16*)(ws + OFF_GVT); u16* GG = (u16*)(ws + OFF_GG);
        float* LR = (float*)(ws + OFF_LR);
        const int lane = tid & 63; unsigned char* wl = lds + (tid >> 6) * 16384;
        const int m0 = mt * 256 + wm * 64;
        const bool lat = m0 < T_LAT;
        const int nb = nt * 2 + wn;
        auto put_nat = [&](int tn, int tm, int g, u32x2 p) { const int m = tm * 32 + l31; *(u32x2*)(wl + m * 256 + (((tn * 4 + g) ^ (m & 15)) << 4) + hh * 8) = p; };
        auto put_tr = [&](int tn, int tm, int g, u32x2 p) { u16* t = (u16*)(wl + (tn * 32 + 8 * g + 4 * hh) * 128 + (tm * 32 + l31) * 2);
            t[0] = (u16)(p.x & 0xffffu); t[64] = (u16)(p.x >> 16); t[128] = (u16)(p.y & 0xffffu); t[192] = (u16)(p.y >> 16); };
        auto flush_nat = [&](u16* plane, int ld, int col0) {
            asm volatile("s_waitcnt lgkmcnt(0)" ::: "memory"); __builtin_amdgcn_wave_barrier();
#pragma unroll
            for (int i = 0; i < 16; ++i) { const int m = i * 4 + (lane >> 4), ch = lane & 15; const u32x4 v = *(const u32x4*)(wl + m * 256 + ((ch ^ (m & 15)) << 4));
                *(u32x4*)(plane + (size_t)(m0 + m) * ld + col0 + ch * 8) = v; }
            asm volatile("s_waitcnt lgkmcnt(0)" ::: "memory"); __builtin_amdgcn_wave_barrier(); };
        auto flush_tr = [&](u16* planeT, int row0) {
            asm volatile("s_waitcnt lgkmcnt(0)" ::: "memory"); __builtin_amdgcn_wave_barrier();
#pragma unroll
            for (int i = 0; i < 16; ++i) { const int n = i * 8 + (lane >> 3), ch = lane & 7; const u32x4 v = *(const u32x4*)(wl + n * 128 + ch * 16);
                *(u32x4*)(planeT + (size_t)(row0 + n) * T_ALL + m0 + ch * 8) = v; }
            asm volatile("s_waitcnt lgkmcnt(0)" ::: "memory"); __builtin_amdgcn_wave_barrier(); };
        if (nb < 8) {
            const int head = nb & 3; const bool isK = nb >= 4; const float s = isK ? 0.08838834764831845f : 1.f;
            const f32x2* tabR = (const f32x2*)(ws + OFF_TABR); const f32x2* tabC = (const f32x2*)(ws + OFF_TABC);
#pragma unroll
            for (int tm = 0; tm < 2; ++tm) {
                const int m = m0 + tm * 32 + l31; const int l = m & (SEQ - 1);
#pragma unroll
                for (int tn = 0; tn < 2; ++tn) {
                    const f32x2* tab = (tn == 0) ? tabR + (l >> 6) * 32 : tabC + (l & 63) * 32;
#pragma unroll
                    for (int r = 0; r < 16; ++r) { const float a = acc[tn][tm][r] * s, b = acc[tn + 2][tm][r] * s;
                        if (lat) { const f32x2 cs = tab[acc_row(r, hh)]; acc[tn][tm][r] = a * cs.x - b * cs.y; acc[tn + 2][tm][r] = b * cs.x + a * cs.y; } else { acc[tn][tm][r] = a; acc[tn + 2][tm][r] = b; } }
                }
            }
#pragma unroll
            for (int tn = 0; tn < 4; ++tn)
#pragma unroll
                for (int tm = 0; tm < 2; ++tm)
#pragma unroll
                    for (int g = 0; g < 4; ++g) { u32x2 p; p.x = pk2(acc[tn][tm][4 * g], acc[tn][tm][4 * g + 1]); p.y = pk2(acc[tn][tm][4 * g + 2], acc[tn][tm][4 * g + 3]); put_nat(tn, tm, g, p); }
            flush_nat(isK ? RK : RQ, 512, head * 128);
            if (isK) {
#pragma unroll
                for (int tn = 0; tn < 4; ++tn)
#pragma unroll
                    for (int tm = 0; tm < 2; ++tm)
#pragma unroll
                        for (int g = 0; g < 4; ++g) { u32x2 p; p.x = pk2(acc[tn][tm][4 * g], acc[tn][tm][4 * g + 1]); p.y = pk2(acc[tn][tm][4 * g + 2], acc[tn][tm][4 * g + 3]); put_tr(tn, tm, g, p); }
                flush_tr(RKT, head * 128);
            }
        } else if (nb >= 28) {
            if (nb == 28) {
#pragma unroll
                for (int tm = 0; tm < 2; ++tm) { const int m = m0 + tm * 32 + l31;
#pragma unroll
                    for (int g = 0; g < 4; ++g) { f32x4 v; v.x = acc[0][tm][4 * g]; v.y = acc[0][tm][4 * g + 1]; v.z = acc[0][tm][4 * g + 2]; v.w = acc[0][tm][4 * g + 3];
                        *(f32x4*)(LR + (size_t)m * 32 + 8 * g + 4 * hh) = v; } }
            }
        } else {
            int cls, sub;
            if (nb < 12) { cls = 0; sub = nb - 8; } else if (nb < 16) { cls = 1; sub = nb - 12; } else if (nb < 18) { cls = 2; sub = nb - 16; }
            else if (nb < 20) { cls = 3; sub = nb - 18; } else if (nb < 24) { cls = 4; sub = nb - 20; } else { cls = 5; sub = nb - 24; }
            const bool nat = (cls == 1 || cls == 5) ? lat : (cls == 2 || cls == 3), tr = (cls == 0 || cls == 3 || cls == 4);
            if (nat) {
#pragma unroll
                for (int tn = 0; tn < 4; ++tn)
#pragma unroll
                    for (int tm = 0; tm < 2; ++tm)
#pragma unroll
                        for (int g = 0; g < 4; ++g) { float v[4];
#pragma unroll
                            for (int e = 0; e < 4; ++e) { const float x = acc[tn][tm][4 * g + e]; v[e] = (cls == 1 || cls == 5) ? silu_fast(x) : (cls == 2 ? x * 0.125f : x); }
                            u32x2 p; p.x = pk2(v[0], v[1]); p.y = pk2(v[2], v[3]); put_nat(tn, tm, g, p); }
                flush_nat(cls == 1 ? RG : (cls == 5 ? GG : (cls == 2 ? GQ : GK)), (cls == 2 || cls == 3) ? 256 : 512, sub * 128);
            }
            if (tr) {
#pragma unroll
                for (int tn = 0; tn < 4; ++tn)
#pragma unroll
                    for (int tm = 0; tm < 2; ++tm)
#pragma unroll
                        for (int g = 0; g < 4; ++g) { u32x2 p; p.x = pk2(acc[tn][tm][4 * g], acc[tn][tm][4 * g + 1]); p.y = pk2(acc[tn][tm][4 * g + 2], acc[tn][tm][4 * g + 3]); put_tr(tn, tm, g, p); }
                flush_tr(cls == 0 ? RVT : (cls == 3 ? GKT : GVT), sub * 128);
            }
        }
        __syncthreads();
    }
};
struct EpiOut {
    __device__ __forceinline__ void prefetch(unsigned char*, int, int, int, int) const {}
    const float* x; const float* mod; u16* out;
    __device__ __forceinline__ void operator()(f32x16 (&acc)[4][2], int mt, int nt, int wm, int wn, int l31, int hh, unsigned char*, int) const {
#pragma unroll
        for (int tn = 0; tn < 4; ++tn)
#pragma unroll
            for (int tm = 0; tm < 2; ++tm) { const int m = mt * 256 + wm * 64 + tm * 32 + l31; const float* g1 = mod + (m >> 13) * 6144 + 2 * 1024;
#pragma unroll
                for (int gp = 0; gp < 2; ++gp) { u32x2 p[2];
#pragma unroll
                    for (int e = 0; e < 2; ++e) { const int g = 2 * gp + e; const int n = nt * 256 + wn * 128 + tn * 32 + 8 * g + 4 * hh;
                        const f32x4 xv = *(const f32x4*)(x + (size_t)m * D + n), gv = *(const f32x4*)(g1 + n); f32x4 a; a.x = acc[tn][tm][4 * g]; a.y = acc[tn][tm][4 * g + 1]; a.z = acc[tn][tm][4 * g + 2]; a.w = acc[tn][tm][4 * g + 3];
                        const f32x4 o = xv + gv * a; p[e].x = pk2(o.x, o.y); p[e].y = pk2(o.z, o.w); }
                    const auto s0 = __builtin_amdgcn_permlane32_swap(p[0].x, p[1].x, false, false), s1 = __builtin_amdgcn_permlane32_swap(p[0].y, p[1].y, false, false);
                    u32x4 v; v.x = s0[0]; v.y = s1[0]; v.z = s0[1]; v.w = s1[1];
                    *(u32x4*)(out + (size_t)m * D + nt * 256 + wn * 128 + tn * 32 + 16 * gp + 8 * hh) = v; } }
    }
};
__device__ __forceinline__ unsigned sortable(float x) { const unsigned u = __float_as_uint(x); return (u & 0x80000000u) ? ~u : (u | 0x80000000u); }
__device__ __forceinline__ float unsortable(unsigned s) { const unsigned u = (s & 0x80000000u) ? (s & 0x7fffffffu) : ~s; return __uint_as_float(u); }
#define TOPK_INSERT(t, v) do { const unsigned _v = (v); _Pragma("unroll") for (int _s = 15; _s >= 1; --_s) { const unsigned _a = (t)[_s - 1], _b = (t)[_s]; (t)[_s] = max(min(_a, _b), min(max(_a, _b), _v)); } (t)[0] = max((t)[0], _v); } while (0)
#define CE_DESC(x, y) do { const unsigned hi_ = max((x), (y)), lo_ = min((x), (y)); (x) = hi_; (y) = lo_; } while (0)
__device__ __forceinline__ void bsort16(unsigned (&t)[16]) {
#pragma unroll
    for (int p = 1; p < 16; p <<= 1)
#pragma unroll
        for (int k = p; k >= 1; k >>= 1)
#pragma unroll
            for (int j = k % p; j <= 15 - k; j += 2 * k)
#pragma unroll
                for (int i = 0; i < k; ++i) if (i + j + k <= 15 && (i + j) / (2 * p) == (i + j + k) / (2 * p)) CE_DESC(t[i + j], t[i + j + k]);
}
__device__ __forceinline__ void bmerge16(unsigned (&a)[16], const unsigned (&b)[16]) {
#pragma unroll
    for (int i = 0; i < 16; ++i) a[i] = max(a[i], b[15 - i]);
#pragma unroll
    for (int j = 8; j > 0; j >>= 1)
#pragma unroll
        for (int i = 0; i < 16; ++i) { const int l = i ^ j; if (l > i) CE_DESC(a[i], a[l]); }
}
struct EpiQTopk {
    __device__ __forceinline__ void prefetch(unsigned char* lds, int nt, int wm, int wn, int tid) const {
        const int lane_ = tid & 63, head = nt, half = wn; const u16* KG = (const u16*)(ws + (half ? OFF_K2 : OFF_K1)) + (size_t)head * 128 * 128;
        unsigned char* kl = lds + half * 32768 + wm * 8192;
#pragma unroll 1
        for (int i_ = 0; i_ < 8; ++i_) { const int row = wm * 32 + i_ * 4 + (lane_ >> 4), c = (lane_ & 15) ^ (row & 15);
            __builtin_amdgcn_global_load_lds((const unsigned*)(KG + row * 128 + c * 8), (__attribute__((address_space(3))) unsigned*)(kl + i_ * 1024), 16, 0, 0); }
    }
    unsigned char* ws;
    __device__ __forceinline__ void operator()(f32x16 (&acc)[4][2], int mt, int nt, int wm_, int wn_, int l31_, int hh_, unsigned char* lds, int tid_) const {
        const int wm = opaque_i(wm_), wn = opaque_i(wn_), l31 = opaque_i(l31_), hh = opaque_i(hh_), tid = opaque_i(tid_);
        const int head = nt, half = wn;
        const unsigned char* KL = lds + half * 32768;
        unsigned* LST = (unsigned*)(lds + 65536);
        u16* IDX = (u16*)(ws + OFF_IDX); float* GW = (float*)(ws + OFF_GW);
        bf16x8 qf[2][8];
#pragma unroll
        for (int tm = 0; tm < 2; ++tm)
#pragma unroll
            for (int s8 = 0; s8 < 8; ++s8) { const int tn = s8 >> 1, r0 = 8 * (s8 & 1); u32x4 w;
                w.x = pk2(acc[tn][tm][r0 + 0], acc[tn][tm][r0 + 1]); w.y = pk2(acc[tn][tm][r0 + 2], acc[tn][tm][r0 + 3]); w.z = pk2(acc[tn][tm][r0 + 4], acc[tn][tm][r0 + 5]); w.w = pk2(acc[tn][tm][r0 + 6], acc[tn][tm][r0 + 7]);
                qf[tm][s8] = __builtin_bit_cast(bf16x8, w); }
        __builtin_amdgcn_sched_barrier(0);
        asm volatile("s_waitcnt vmcnt(0)" ::: "memory"); __syncthreads();
#pragma unroll
        for (int tm = 0; tm < 2; ++tm) {
            f32x16 sc[4];
#pragma unroll
            for (int kn = 0; kn < 4; ++kn)
#pragma unroll
                for (int r = 0; r < 16; ++r) sc[kn][r] = 0.f;
#pragma unroll
            for (int ks = 0; ks < 8; ++ks)
#pragma unroll
                for (int kn = 0; kn < 4; ++kn) { const bf16x8 a = *(const bf16x8*)(KL + off256(kn * 32 + l31, 2 * ks + hh)); sc[kn] = MFMA(a, qf[tm][ks], sc[kn]); }
            unsigned t[16], t1[16], t2[16], t3[16];
#pragma unroll
            for (int r = 0; r < 16; ++r) { const int nr = acc_row(r, hh);
                t[r] = (sortable(sc[0][r]) & 0xFFFFFF80u) | (unsigned)(127 - nr); t1[r] = (sortable(sc[1][r]) & 0xFFFFFF80u) | (unsigned)(127 - 32 - nr);
                t2[r] = (sortable(sc[2][r]) & 0xFFFFFF80u) | (unsigned)(127 - 64 - nr); t3[r] = (sortable(sc[3][r]) & 0xFFFFFF80u) | (unsigned)(127 - 96 - nr); }
            bsort16(t); bsort16(t1); bsort16(t2); bsort16(t3);
            bmerge16(t, t1); bmerge16(t2, t3); bmerge16(t, t2);
            unsigned pt[16];
#pragma unroll
            for (int s = 0; s < 16; ++s) { const auto r = __builtin_amdgcn_permlane32_swap(t[s], t[s], false, false); pt[s] = hh ? r[0] : r[1]; }
            bmerge16(t, pt);
            if (hh == 0) {
                u32x4* dst = (u32x4*)(LST + ((wm * 64 + tm * 32 + l31) * 2 + half) * 16);
#pragma unroll
                for (int q = 0; q < 4; ++q) { u32x4 v; v.x = t[4 * q]; v.y = t[4 * q + 1]; v.z = t[4 * q + 2]; v.w = t[4 * q + 3]; dst[q] = v; }
            }
            __builtin_amdgcn_sched_barrier(0);
        }
        __syncthreads();
        if (tid < 256) {
            const int tok = tid; const int mm = mt * 256 + tok;
            unsigned la[16], lb[16];
#pragma unroll
            for (int q = 0; q < 4; ++q) { const u32x4 va = ((const u32x4*)(LST + (tok * 2) * 16))[q], vb = ((const u32x4*)(LST + (tok * 2 + 1) * 16))[q];
                la[4 * q] = va.x; la[4 * q + 1] = va.y; la[4 * q + 2] = va.z; la[4 * q + 3] = va.w; lb[4 * q] = vb.x; lb[4 * q + 1] = vb.y; lb[4 * q + 2] = vb.z; lb[4 * q + 3] = vb.w; }
            float va_[16], vb_[16];
#pragma unroll
            for (int s = 0; s < 16; ++s) { va_[s] = unsortable(la[s] & 0xFFFFFF80u); vb_[s] = unsortable(lb[s] & 0xFFFFFF80u); }
            unsigned t2[16];
#pragma unroll
            for (int b = 0; b < 16; ++b) t2[b] = (sortable(va_[0] + vb_[b]) & 0xFFFFFF00u) | (unsigned)(255 - b);
#pragma unroll
            for (int a = 1; a < 16; ++a)
#pragma unroll
                for (int b = 0; b < 16; ++b) if ((a + 1) * (b + 1) <= 16) { const unsigned key = (sortable(va_[a] + vb_[b]) & 0xFFFFFF00u) | (unsigned)(255 - (a * 16 + b)); TOPK_INSERT(t2, key); }
            float ts[16]; const float mx = unsortable(t2[0] & 0xFFFFFF00u); float sum = 0.f;
#pragma unroll
            for (int s = 0; s < 16; ++s) { ts[s] = __expf(unsortable(t2[s] & 0xFFFFFF00u) - mx); sum += ts[s]; }
            const float inv = 1.f / sum;
            int io[16];
#pragma unroll
            for (int s = 0; s < 16; ++s) { const int ab = 255 - (int)(t2[s] & 255u); const int a = ab >> 4, b = ab & 15;
                const int i1 = 127 - (int)(LST[(tok * 2) * 16 + a] & 127u), i2 = 127 - (int)(LST[(tok * 2 + 1) * 16 + b] & 127u); io[s] = i1 * 128 + i2; ts[s] *= inv; }
            u32x4* ip = (u32x4*)(IDX + (size_t)mm * 128 + head * 16); f32x4* gp = (f32x4*)(GW + (size_t)mm * 128 + head * 16);
#pragma unroll
            for (int q = 0; q < 2; ++q) { u32x4 v; v.x = (unsigned)io[8 * q] | ((unsigned)io[8 * q + 1] << 16); v.y = (unsigned)io[8 * q + 2] | ((unsigned)io[8 * q + 3] << 16); v.z = (unsigned)io[8 * q + 4] | ((unsigned)io[8 * q + 5] << 16); v.w = (unsigned)io[8 * q + 6] | ((unsigned)io[8 * q + 7] << 16); ip[q] = v; }
#pragma unroll
            for (int q = 0; q < 4; ++q) { f32x4 g; g.x = ts[4 * q]; g.y = ts[4 * q + 1]; g.z = ts[4 * q + 2]; g.w = ts[4 * q + 3]; gp[q] = g; }
        }
        __syncthreads();
    }
};

struct HookNone { __device__ __forceinline__ void issue(int, int) {} __device__ __forceinline__ void finish(int, int) {} __device__ __forceinline__ void rotate() {} __device__ __forceinline__ void finish_prev(int) {} };
struct HookDown {
    const float* src; unsigned char* dst; float* dsc; int gw, NGW, ln, ilim; f32x4 v[2][4]; float sck;
    __device__ __forceinline__ void issue(int t, int nch) { const int per = 8 / nch;
#pragma unroll
        for (int u = 0; u < 2; ++u) if (u < per && t * per + u < ilim) { const float* p = src + (size_t)(gw + NGW * (t * per + u)) * 1024 + ln * 16;
#pragma unroll
            for (int q = 0; q < 4; ++q) v[u][q] = *(const f32x4*)(p + 4 * q); } }
    template <int U> __device__ __forceinline__ void emit(int it) { const int e = gw + NGW * it; float mx = 0.f;
#pragma unroll
        for (int q = 0; q < 4; ++q) mx = fmaxf(mx, fmaxf(fmaxf(fabsf(v[U][q].x), fabsf(v[U][q].y)), fmaxf(fabsf(v[U][q].z), fabsf(v[U][q].w))));
        mx = fmaxf(wave_max(mx), 1e-30f); const float qsc = 127.f / mx; u32x4 o;
        o.x = q8x4(v[U][0].x, v[U][0].y, v[U][0].z, v[U][0].w, qsc); o.y = q8x4(v[U][1].x, v[U][1].y, v[U][1].z, v[U][1].w, qsc); o.z = q8x4(v[U][2].x, v[U][2].y, v[U][2].z, v[U][2].w, qsc); o.w = q8x4(v[U][3].x, v[U][3].y, v[U][3].z, v[U][3].w, qsc);
        *(u32x4*)(dst + (size_t)(ln >> 3) * 2097152 + (size_t)e * 128 + (size_t)(ln & 7) * 16) = o;
        if (ln == it) sck = mx * (1.f / 127.f); }
    __device__ __forceinline__ void finish(int t, int nch) { const int per = 8 / nch; if (t * per < ilim) emit<0>(t * per); if (per == 2 && t * per + 1 < ilim) emit<1>(t * per + 1); }
    __device__ __forceinline__ void rotate() {
#pragma unroll
        for (int q = 0; q < 4; ++q) v[1][q] = v[0][q]; }
    __device__ __forceinline__ void finish_prev(int it) { if (it >= 0 && it < ilim) emit<1>(it); }
    __device__ __forceinline__ void flush() { if (ln < 8 && ln < ilim) dsc[gw + NGW * ln] = sck; }
};
struct HookUp {
    const float* src; unsigned char* dst; int gt, NGT, ilim; f32x4 a[2][4];
    __device__ __forceinline__ void issue(int t, int nch) { const int per = 8 / nch;
#pragma unroll
        for (int u = 0; u < 2; ++u) if (u < per && t * per + u < ilim) { const float* p = src + (size_t)(gt + NGT * (t * per + u)) * 16;
#pragma unroll
            for (int q = 0; q < 4; ++q) a[u][q] = *(const f32x4*)(p + 4 * q); } }
    template <int U> __device__ __forceinline__ void emit(int it) { const int ch = gt + NGT * it; u32x4 o; unsigned ow[4];
#pragma unroll
        for (int q = 0; q < 4; ++q) { int p = 0; p = __builtin_amdgcn_cvt_pk_fp8_f32(a[U][q].x * UP_SCALE, a[U][q].y * UP_SCALE, p, false); p = __builtin_amdgcn_cvt_pk_fp8_f32(a[U][q].z * UP_SCALE, a[U][q].w * UP_SCALE, p, true); ow[q] = (unsigned)p; }
        o.x = ow[0]; o.y = ow[1]; o.z = ow[2]; o.w = ow[3];
        *(u32x4*)(dst + (size_t)((ch & 63) >> 3) * 2097152 + (size_t)(ch >> 6) * 128 + (size_t)(ch & 7) * 16) = o; }
    __device__ __forceinline__ void finish(int t, int nch) { const int per = 8 / nch; if (t * per < ilim) emit<0>(t * per); if (per == 2 && t * per + 1 < ilim) emit<1>(t * per + 1); }
    __device__ __forceinline__ void rotate() {
#pragma unroll
        for (int q = 0; q < 4; ++q) a[1][q] = a[0][q]; }
    __device__ __forceinline__ void finish_prev(int it) { if (it >= 0 && it < ilim) emit<1>(it); }
};
constexpr int RS_Q = 0, RS_K = 16384, RS_KT = 32768, RS_VT = 49152, RS_P = 65536, RS_ST = 73728;
constexpr int GS_Q = 0, GS_K = 8192, GS_KT = 16384, GS_VT = 24576, GS_P = 40960, GS_ST = 49152, GS_LR = 65536, GS_SEG = 69632, GS_GL = 71680, GS_G = 71936;

template <int MODE, class Hook>
__device__ __forceinline__ void scan_ret2(const Args& A, unsigned char* lds, int gr, int k, int tid, Hook& hook) {
    const int lane = tid & 63, wave = tid >> 6, l31 = lane & 31, hh = lane >> 5;
    const int b = gr >> 3, h = (gr >> 1) & 3, dir = gr & 1;
    const u16* RQ = (const u16*)(A.ws + OFF_RQ); const u16* RK = (const u16*)(A.ws + OFF_RK); const u16* RKT = (const u16*)(A.ws + OFF_RKT); const u16* RVT = (const u16*)(A.ws + OFF_RVT);
    u16* OUT = (u16*)(A.ws + (dir ? OFF_ORB : OFF_ORF));
    const float lg = logsig_f(A.in[dir ? 10 : 9][h]); const float lg2c = lg * 1.4426950408889634f; float lg2 = lg2c;
    const float cd = __builtin_amdgcn_exp2f(lg2c * 64.f);
    float kd[8];
#pragma unroll
    for (int q = 0; q < 8; ++q) { const int j = (tid & 7) * 8 + q; kd[q] = __builtin_amdgcn_exp2f(lg2c * (dir ? (float)j : (float)(63 - j))); }
    const float qdc = __builtin_amdgcn_exp2f(lg2c * (dir ? (float)(64 - ((wave & 1) * 32 + l31)) : (float)((wave & 1) * 32 + l31 + 1)));
    const int nch = (k == 0) ? 4 : 8;
    const int dt = wave >> 1, wt0 = (wave & 1) * 2;
    f32x16 S[2];
    if (MODE == 1) {
        const float* slot = (const float*)(A.ws + OFF_SLOT_R) + (size_t)(gr * 16 + k - 1) * 16384;
#pragma unroll
        for (int q = 0; q < 2; ++q)
#pragma unroll
            for (int g = 0; g < 4; ++g) { const f32x4 v = ((const f32x4*)slot)[((dt * 4 + wt0 + q) * 4 + g) * 64 + lane]; S[q][4 * g] = v.x; S[q][4 * g + 1] = v.y; S[q][4 * g + 2] = v.z; S[q][4 * g + 3] = v.w; }
    } else {
#pragma unroll
        for (int q = 0; q < 2; ++q)
#pragma unroll
            for (int r = 0; r < 16; ++r) S[q][r] = 0.f;
    }
    u32x4 rq[2], rk[2], rkt[2], rvt[2];
    auto tok0_of = [&](int t) -> int { if (k == 0) { const int cc = dir ? 3 - t : t; return T_LAT + b * CTXL + cc * 64; } const int sc = dir ? 16 - k : k - 1; const int c = sc * 8 + (dir ? 7 - t : t); return b * SEQ + c * 64; };
    auto issue = [&](int t) {
        const int tok0 = tok0_of(t);
#pragma unroll
        for (int e = 0; e < 2; ++e) { const int idx = tid + 512 * e;
            if (MODE == 1) { const int row = idx >> 4, ch = idx & 15; rq[e] = *(const u32x4*)(RQ + (size_t)(tok0 + row) * 512 + h * 128 + ch * 8); rk[e] = *(const u32x4*)(RK + (size_t)(tok0 + row) * 512 + h * 128 + ch * 8); }
            const int rowt = idx >> 3, cht = idx & 7; rkt[e] = *(const u32x4*)(RKT + (size_t)(h * 128 + rowt) * T_ALL + tok0 + cht * 8); rvt[e] = *(const u32x4*)(RVT + (size_t)(h * 128 + rowt) * T_ALL + tok0 + cht * 8); }
    };
    auto stage = [&]() {
#pragma unroll
        for (int e = 0; e < 2; ++e) { const int idx = tid + 512 * e;
            if (MODE == 1) { const int row = idx >> 4, ch = idx & 15; *(u32x4*)(lds + RS_Q + off256(row, ch)) = rq[e]; *(u32x4*)(lds + RS_K + off256(row, ch)) = rk[e]; }
            const int rowt = idx >> 3, cht = idx & 7; u32x4 v = rkt[e]; unsigned w[4] = {v.x, v.y, v.z, v.w};
#pragma unroll
            for (int q = 0; q < 4; ++q) w[q] = pk2(bf_lo(w[q]) * kd[2 * q], bf_hi(w[q]) * kd[2 * q + 1]);
            v.x = w[0]; v.y = w[1]; v.z = w[2]; v.w = w[3];
            *(u32x4*)(lds + RS_KT + off128(rowt, cht)) = v; *(u32x4*)(lds + RS_VT + off128(rowt, cht)) = rvt[e]; }
    };
    auto put_st = [&]() {
#pragma unroll
        for (int q = 0; q < 2; ++q)
#pragma unroll
            for (int g = 0; g < 4; ++g) { u32x2 p; p.x = pk2(S[q][4 * g], S[q][4 * g + 1]); p.y = pk2(S[q][4 * g + 2], S[q][4 * g + 3]);
                *(u32x2*)(lds + RS_ST + off256((wt0 + q) * 32 + l31, dt * 4 + g) + hh * 8) = p; }
    };
    auto do_u = [&]() {
#pragma unroll
        for (int q = 0; q < 2; ++q)
#pragma unroll
            for (int r = 0; r < 16; ++r) S[q][r] *= cd;
#pragma unroll
        for (int ks = 0; ks < 4; ++ks) { const bf16x8 a = *(const bf16x8*)(lds + RS_KT + off128(dt * 32 + l31, 2 * ks + hh));
#pragma unroll
            for (int q = 0; q < 2; ++q) { const bf16x8 bv = *(const bf16x8*)(lds + RS_VT + off128((wt0 + q) * 32 + l31, 2 * ks + hh)); S[q] = MFMA(a, bv, S[q]); } }
    };
    float mk[16];
    if (MODE == 1) { const int tj_ = (wave >> 1) & 1, ti_ = wave & 1, i_ = ti_ * 32 + l31;
#pragma unroll
        for (int r = 0; r < 16; ++r) { const int j_ = tj_ * 32 + acc_row(r, hh); const int dlt = dir ? (j_ - i_) : (i_ - j_); mk[r] = dlt >= 0 ? __builtin_amdgcn_exp2f(lg2c * (float)dlt) : 0.f; } }
    issue(0);
    if (MODE == 1) put_st();
    for (int t = 0; t < nch; ++t) {
        const int tok0 = tok0_of(t);
        stage();
        __syncthreads();
        if (t + 1 < nch) issue(t + 1);
        if (MODE == 0) {
            if (nch == 8) { hook.rotate(); hook.issue(t, nch); hook.finish_prev(t - 1); do_u(); } else { hook.issue(t, nch); do_u(); hook.finish(t, nch); }
            __syncthreads(); continue; }
        if (wave < 4) {
            const int tj = wave >> 1, ti = wave & 1; f32x16 P;
#pragma unroll
            for (int r = 0; r < 16; ++r) P[r] = 0.f;
#pragma unroll
            for (int ks = 0; ks < 8; ++ks) { const bf16x8 a = *(const bf16x8*)(lds + RS_K + off256(tj * 32 + l31, 2 * ks + hh)); const bf16x8 bq = *(const bf16x8*)(lds + RS_Q + off256(ti * 32 + l31, 2 * ks + hh)); P = MFMA(a, bq, P); }
            const int i = ti * 32 + l31;
#pragma unroll
            for (int g = 0; g < 4; ++g) { float v[4];
#pragma unroll
                for (int e = 0; e < 4; ++e) v[e] = P[4 * g + e] * mk[4 * g + e];
                u32x2 p; p.x = pk2(v[0], v[1]); p.y = pk2(v[2], v[3]);
                *(u32x2*)(lds + RS_P + off128(i, tj * 4 + g) + hh * 8) = p; }
        } else do_u();
        __syncthreads();
        {
            const int wt = wave >> 1, ti = wave & 1; f32x16 O;
#pragma unroll
            for (int r = 0; r < 16; ++r) O[r] = 0.f;
#pragma unroll
            for (int ks = 0; ks < 8; ++ks) { const bf16x8 a = *(const bf16x8*)(lds + RS_ST + off256(wt * 32 + l31, 2 * ks + hh)); const bf16x8 bq = *(const bf16x8*)(lds + RS_Q + off256(ti * 32 + l31, 2 * ks + hh)); O = MFMA(a, bq, O); }
            const int i = ti * 32 + l31; const float qd = qdc;
#pragma unroll
            for (int r = 0; r < 16; ++r) O[r] *= qd;
#pragma unroll
            for (int ks = 0; ks < 4; ++ks) { const bf16x8 a = *(const bf16x8*)(lds + RS_VT + off128(wt * 32 + l31, 2 * ks + hh)); const bf16x8 bp = *(const bf16x8*)(lds + RS_P + off128(ti * 32 + l31, 2 * ks + hh)); O = MFMA(a, bp, O); }
            u16* op = OUT + (size_t)(tok0 + i) * 512 + h * 128 + wt * 32;
#pragma unroll
            for (int gp = 0; gp < 2; ++gp) {
                u32x2 p0, p1; p0.x = pk2(O[8 * gp], O[8 * gp + 1]); p0.y = pk2(O[8 * gp + 2], O[8 * gp + 3]); p1.x = pk2(O[8 * gp + 4], O[8 * gp + 5]); p1.y = pk2(O[8 * gp + 6], O[8 * gp + 7]);
                const auto s0 = __builtin_amdgcn_permlane32_swap(p0.x, p1.x, false, false), s1 = __builtin_amdgcn_permlane32_swap(p0.y, p1.y, false, false);
                u32x4 v; v.x = s0[0]; v.y = s1[0]; v.z = s0[1]; v.w = s1[1]; *(u32x4*)(op + 16 * gp + 8 * hh) = v; }
        }
        if (wave < 4) do_u();
        __syncthreads();
        if (t + 1 < nch) put_st();
    }
    if (MODE == 0) {
        if (nch == 8) { hook.rotate(); hook.finish_prev(nch - 1); }
        float* slot = (float*)(A.ws + OFF_SLOT_R) + (size_t)(gr * 16 + k) * 16384;
#pragma unroll
        for (int q = 0; q < 2; ++q)
#pragma unroll
            for (int g = 0; g < 4; ++g) { f32x4 v; v.x = S[q][4 * g]; v.y = S[q][4 * g + 1]; v.z = S[q][4 * g + 2]; v.w = S[q][4 * g + 3]; ((f32x4*)slot)[((dt * 4 + wt0 + q) * 4 + g) * 64 + lane] = v; }
    }
}

template <int MODE, class Hook>
__device__ __forceinline__ void scan_gla2(const Args& A, unsigned char* lds, int gr, int k, int tid, Hook& hook) {
    const int lane = tid & 63, wave = tid >> 6, l31 = lane & 31, hh = lane >> 5;
    const int b = gr >> 3, h = (gr >> 1) & 3, dir = gr & 1;
    const u16* GQ = (const u16*)(A.ws + OFF_GQ); const u16* GK = (const u16*)(A.ws + OFF_GK); const u16* GKT = (const u16*)(A.ws + OFF_GKT); const u16* GVT = (const u16*)(A.ws + OFF_GVT);
    const float* LR = (const float*)(A.ws + OFF_LR);
    u16* OUT = (u16*)(A.ws + (dir ? OFF_OGB : OFF_OGF));
    const float* up = A.in[dir ? 13 : 11]; const float* bias = A.in[dir ? 14 : 12];
    const int dmy = tid & 63, seg = tid >> 6;
    float upr[16];
#pragma unroll
    for (int r = 0; r < 16; ++r) upr[r] = up[r * 256 + h * 64 + dmy];
    const float bs = bias[h * 64 + dmy];
    const int nch = (k == 0) ? 4 : 8;
    const int dt = wave >> 2, wt = wave & 3;
    f32x16 S;
    if (MODE == 1) {
        const float* slot = (const float*)(A.ws + OFF_SLOT_G) + (size_t)(gr * 16 + k - 1) * 8192;
#pragma unroll
        for (int g = 0; g < 4; ++g) { const f32x4 v = ((const f32x4*)slot)[(wave * 4 + g) * 64 + lane]; S[4 * g] = v.x; S[4 * g + 1] = v.y; S[4 * g + 2] = v.z; S[4 * g + 3] = v.w; }
    } else {
#pragma unroll
        for (int r = 0; r < 16; ++r) S[r] = 0.f;
    }
    float gsum = 0.f;
    u32x4 rq, rk, rkt, rvt[2]; f32x4 rlr;
    auto tok0_of = [&](int t) -> int { if (k == 0) { const int cc = dir ? 3 - t : t; return T_LAT + b * CTXL + cc * 64; } const int sc = dir ? 16 - k : k - 1; const int c = sc * 8 + (dir ? 7 - t : t); return b * SEQ + c * 64; };
    auto issue = [&](int t) {
        const int tok0 = tok0_of(t); const int row = tid >> 3, ch = tid & 7;
        if (MODE == 1) { rq = *(const u32x4*)(GQ + (size_t)(tok0 + row) * 256 + h * 64 + ch * 8); rk = *(const u32x4*)(GK + (size_t)(tok0 + row) * 256 + h * 64 + ch * 8); }
        rkt = *(const u32x4*)(GKT + (size_t)(h * 64 + row) * T_ALL + tok0 + ch * 8);
#pragma unroll
        for (int e = 0; e < 2; ++e) rvt[e] = *(const u32x4*)(GVT + (size_t)(h * 128 + e * 64 + row) * T_ALL + tok0 + ch * 8);
    };
    auto put_st = [&]() {
#pragma unroll
        for (int g = 0; g < 4; ++g) { u32x2 p; p.x = pk2(S[4 * g], S[4 * g + 1]); p.y = pk2(S[4 * g + 2], S[4 * g + 3]);
            *(u32x2*)(lds + GS_ST + off128(wt * 32 + l31, dt * 4 + g) + hh * 8) = p; }
    };
    float* LRs = (float*)(lds + GS_LR); float* SEGs = (float*)(lds + GS_SEG); float* GLs = (float*)(lds + GS_GL); float* GL2 = (float*)(lds + 88576); float* Gs = (float*)(lds + GS_G);
    auto do_u = [&](const float* GLb) {
#pragma unroll
        for (int g = 0; g < 4; ++g) { const f32x4 gl = *(const f32x4*)(GLb + dt * 32 + 8 * g + 4 * hh);
            S[4 * g] *= __expf(gl.x); S[4 * g + 1] *= __expf(gl.y); S[4 * g + 2] *= __expf(gl.z); S[4 * g + 3] *= __expf(gl.w); }
#pragma unroll
        for (int ks = 0; ks < 4; ++ks) { const bf16x8 a = *(const bf16x8*)(lds + GS_KT + off128(dt * 32 + l31, 2 * ks + hh)); const bf16x8 bv = *(const bf16x8*)(lds + GS_VT + off128(wt * 32 + l31, 2 * ks + hh)); S = MFMA(a, bv, S); }
    };
    float pre[8];
    auto issue_lr = [&](int t) { if (tid < 256) rlr = *(const f32x4*)(LR + (size_t)(tok0_of(t) + (tid >> 2)) * 32 + dir * 16 + (tid & 3) * 4); };
    auto put_lr = [&]() { if (tid < 256) *(f32x4*)(LRs + (tid >> 2) * 16 + (tid & 3) * 4) = rlr; };
    auto gateB = [&]() {
#pragma unroll
        for (int e = 0; e < 8; ++e) { const f32x4* lr4 = (const f32x4*)(LRs + (seg * 8 + e) * 16); float a = bs;
#pragma unroll
            for (int r4 = 0; r4 < 4; ++r4) { const f32x4 l = lr4[r4]; a += l.x * upr[4 * r4] + l.y * upr[4 * r4 + 1] + l.z * upr[4 * r4 + 2] + l.w * upr[4 * r4 + 3]; }
            pre[e] = logsig_fast(a) * 0.0625f; }
        if (!dir) {
#pragma unroll
            for (int e = 1; e < 8; ++e) pre[e] += pre[e - 1];
            SEGs[seg * 64 + dmy] = pre[7];
        } else {
#pragma unroll
            for (int e = 6; e >= 0; --e) pre[e] += pre[e + 1];
            SEGs[seg * 64 + dmy] = pre[0];
        }
    };
    auto gateC = [&](float* GLb) {
        { float off = 0.f, tot = 0.f;
#pragma unroll
            for (int q = 0; q < 8; ++q) { const float v = SEGs[q * 64 + dmy]; tot += v; if (dir ? (q > seg) : (q < seg)) off += v; }
#pragma unroll
            for (int e = 0; e < 8; ++e) Gs[(seg * 8 + e) * 65 + dmy] = off + pre[e];
            if (seg == 0) { GLb[dmy] = tot; gsum += tot; } }
    };
    issue(0); issue_lr(0);
    if (MODE == 1) put_st();
    put_lr(); if (nch > 1) issue_lr(1);
    __syncthreads();
    gateB();
    __syncthreads();
    gateC(GLs);
    if (nch > 1) { put_lr(); if (nch > 2) issue_lr(2); }
    __syncthreads();
    for (int t = 0; t < nch; ++t) {
        const int tok0 = tok0_of(t);
        float* GLc = (t & 1) ? GL2 : GLs; float* GLn = (t & 1) ? GLs : GL2;
        { const int row = tid >> 3, ch = tid & 7;
            if (MODE == 1) { unsigned w[4] = {rq.x, rq.y, rq.z, rq.w}; const float* g = Gs + row * 65 + ch * 8;
#pragma unroll
                for (int q = 0; q < 4; ++q) w[q] = pk2(bf_lo(w[q]) * __expf(g[2 * q]), bf_hi(w[q]) * __expf(g[2 * q + 1]));
                u32x4 v; v.x = w[0]; v.y = w[1]; v.z = w[2]; v.w = w[3]; *(u32x4*)(lds + GS_Q + off128(row, ch)) = v;
                unsigned wk[4] = {rk.x, rk.y, rk.z, rk.w};
#pragma unroll
                for (int q = 0; q < 4; ++q) wk[q] = pk2(bf_lo(wk[q]) * __expf(-g[2 * q]), bf_hi(wk[q]) * __expf(-g[2 * q + 1]));
                v.x = wk[0]; v.y = wk[1]; v.z = wk[2]; v.w = wk[3]; *(u32x4*)(lds + GS_K + off128(row, ch)) = v; }
            { unsigned w[4] = {rkt.x, rkt.y, rkt.z, rkt.w}; const float gl = GLc[row];
#pragma unroll
                for (int q = 0; q < 4; ++q) { const int j = ch * 8 + 2 * q; w[q] = pk2(bf_lo(w[q]) * __expf(gl - Gs[j * 65 + row]), bf_hi(w[q]) * __expf(gl - Gs[(j + 1) * 65 + row])); }
                u32x4 v; v.x = w[0]; v.y = w[1]; v.z = w[2]; v.w = w[3]; *(u32x4*)(lds + GS_KT + off128(row, ch)) = v; }
#pragma unroll
            for (int e = 0; e < 2; ++e) *(u32x4*)(lds + GS_VT + off128(e * 64 + row, ch)) = rvt[e];
        }
        if (t + 1 < nch) gateB();
        __syncthreads();
        if (t + 1 < nch) issue(t + 1);
        if (MODE == 0) {
            if (nch == 8) { hook.rotate(); hook.issue(t, nch); hook.finish_prev(t - 1); do_u(GLc); } else { hook.issue(t, nch); do_u(GLc); hook.finish(t, nch); }
            if (t + 1 < nch) gateC(GLn);
            if (t + 2 < nch) { put_lr(); if (t + 3 < nch) issue_lr(t + 3); }
            __syncthreads(); continue; }
        if (wave < 4) {
            const int tj = wave >> 1, ti = wave & 1; f32x16 P;
#pragma unroll
            for (int r = 0; r < 16; ++r) P[r] = 0.f;
#pragma unroll
            for (int ks = 0; ks < 4; ++ks) { const bf16x8 a = *(const bf16x8*)(lds + GS_K + off128(tj * 32 + l31, 2 * ks + hh)); const bf16x8 bq = *(const bf16x8*)(lds + GS_Q + off128(ti * 32 + l31, 2 * ks + hh)); P = MFMA(a, bq, P); }
            const int i = ti * 32 + l31;
#pragma unroll
            for (int g = 0; g < 4; ++g) { float v[4];
#pragma unroll
                for (int e = 0; e < 4; ++e) { const int j = tj * 32 + 8 * g + 4 * hh + e; const bool keep = dir ? (j >= i) : (i >= j); v[e] = keep ? P[4 * g + e] : 0.f; }
                u32x2 p; p.x = pk2(v[0], v[1]); p.y = pk2(v[2], v[3]);
                *(u32x2*)(lds + GS_P + off128(i, tj * 4 + g) + hh * 8) = p; }
        } else do_u(GLc);
        if (t + 1 < nch) gateC(GLn);
        if (t + 2 < nch) { put_lr(); if (t + 3 < nch) issue_lr(t + 3); }
        __syncthreads();
        {
            const int ot = wave >> 1, ti = wave & 1; f32x16 O;
#pragma unroll
            for (int r = 0; r < 16; ++r) O[r] = 0.f;
#pragma unroll
            for (int ks = 0; ks < 4; ++ks) { const bf16x8 a = *(const bf16x8*)(lds + GS_ST + off128(ot * 32 + l31, 2 * ks + hh)); const bf16x8 bq = *(const bf16x8*)(lds + GS_Q + off128(ti * 32 + l31, 2 * ks + hh)); O = MFMA(a, bq, O); }
#pragma unroll
            for (int ks = 0; ks < 4; ++ks) { const bf16x8 a = *(const bf16x8*)(lds + GS_VT + off128(ot * 32 + l31, 2 * ks + hh)); const bf16x8 bp = *(const bf16x8*)(lds + GS_P + off128(ti * 32 + l31, 2 * ks + hh)); O = MFMA(a, bp, O); }
            const int i = ti * 32 + l31;
            u16* op = OUT + (size_t)(tok0 + i) * 512 + h * 128 + ot * 32;
#pragma unroll
            for (int gp = 0; gp < 2; ++gp) {
                u32x2 p0, p1; p0.x = pk2(O[8 * gp], O[8 * gp + 1]); p0.y = pk2(O[8 * gp + 2], O[8 * gp + 3]); p1.x = pk2(O[8 * gp + 4], O[8 * gp + 5]); p1.y = pk2(O[8 * gp + 6], O[8 * gp + 7]);
                const auto s0 = __builtin_amdgcn_permlane32_swap(p0.x, p1.x, false, false), s1 = __builtin_amdgcn_permlane32_swap(p0.y, p1.y, false, false);
                u32x4 v; v.x = s0[0]; v.y = s1[0]; v.z = s0[1]; v.w = s1[1]; *(u32x4*)(op + 16 * gp + 8 * hh) = v; }
        }
        if (wave < 4) do_u(GLc);
        __syncthreads();
        if (t + 1 < nch) put_st();
    }
    if (MODE == 0) {
        if (nch == 8) { hook.rotate(); hook.finish_prev(nch - 1); }
        float* slot = (float*)(A.ws + OFF_SLOT_G) + (size_t)(gr * 16 + k) * 8192;
#pragma unroll
        for (int g = 0; g < 4; ++g) { f32x4 v; v.x = S[4 * g]; v.y = S[4 * g + 1]; v.z = S[4 * g + 2]; v.w = S[4 * g + 3]; ((f32x4*)slot)[(wave * 4 + g) * 64 + lane] = v; }
        if (tid < 64) ((float*)(A.ws + OFF_GSUM))[(gr * 16 + k) * 64 + tid] = gsum;
    }
}

__device__ __forceinline__ void scan_combine(const Args& A, int bid, int G, int tid) {
    const int gt = bid * NTHREADS + tid, NGT = G * NTHREADS;
    for (int i = gt; i < 16 * 4096 + 16 * 2048; i += NGT) {
        if (i < 16 * 4096) { const int gr = i >> 12, e4 = i & 4095; const int h = (gr >> 1) & 3, dir = gr & 1;
            const float dec = exp2f(logsig_f(A.in[dir ? 10 : 9][h]) * 1.4426950408889634f * 512.f);
            f32x4* base = (f32x4*)(A.ws + OFF_SLOT_R) + (size_t)gr * 16 * 4096 + e4; f32x4 v[16];
#pragma unroll
            for (int k = 0; k < 16; ++k) v[k] = base[(size_t)k * 4096];
#pragma unroll
            for (int k = 1; k < 16; ++k) { v[k] = v[k - 1] * dec + v[k]; base[(size_t)k * 4096] = v[k]; }
        } else { const int ii = i - 16 * 4096; const int gr = ii >> 11, e4 = ii & 2047;
            const int d0 = ((e4 >> 8) >> 2) * 32 + 8 * ((e4 >> 6) & 3) + 4 * ((e4 & 63) >> 5);
            const float* gs = (const float*)(A.ws + OFF_GSUM) + gr * 16 * 64 + d0;
            f32x4* base = (f32x4*)(A.ws + OFF_SLOT_G) + (size_t)gr * 16 * 2048 + e4; f32x4 v[16]; f32x4 dc[16];
#pragma unroll
            for (int k = 0; k < 16; ++k) { v[k] = base[(size_t)k * 2048]; dc[k] = *(const f32x4*)(gs + k * 64); }
#pragma unroll
            for (int k = 1; k < 16; ++k) { f32x4 ed; ed.x = __expf(dc[k].x); ed.y = __expf(dc[k].y); ed.z = __expf(dc[k].z); ed.w = __expf(dc[k].w); v[k] = v[k - 1] * ed + v[k]; base[(size_t)k * 2048] = v[k]; }
        }
    }
}


__device__ __forceinline__ void phase4(const Args& A, int gw, int NGW, int lane) {
    u16* Y = (u16*)(A.ws + OFF_Y);
    const int niter_ = (NGW == 2048) ? 8 : (T_LAT + NGW - 1) / NGW;
    u32x4 cur[2][3], nxt[2][3];
    auto ld = [&](int tok, u32x4 (&d)[2][3]) {
#pragma unroll
        for (int part = 0; part < 2; ++part) {
            const u16* OF = (const u16*)(A.ws + (part ? OFF_OGF : OFF_ORF)); const u16* OB = (const u16*)(A.ws + (part ? OFF_OGB : OFF_ORB)); const u16* GT = (const u16*)(A.ws + (part ? OFF_GG : OFF_RG));
            d[part][0] = *(const u32x4*)(OF + (size_t)tok * 512 + lane * 8); d[part][1] = *(const u32x4*)(OB + (size_t)tok * 512 + lane * 8); d[part][2] = *(const u32x4*)(GT + (size_t)tok * 512 + lane * 8); } };
    int tok = xcd_row(0, gw, NGW);
    if (tok < T_LAT) ld(tok, cur);
    for (int i_ = 0; i_ < niter_ && tok < T_LAT; ++i_) {
        const int tn = i_ + 1 < niter_ ? xcd_row(i_ + 1, gw, NGW) : T_LAT;
        ld(tn < T_LAT ? tn : tok, nxt);
#pragma unroll
        for (int part = 0; part < 2; ++part) {
            const u32x4 a = cur[part][0], b = cur[part][1], g = cur[part][2];
            const unsigned aw[4] = {a.x, a.y, a.z, a.w}, bw[4] = {b.x, b.y, b.z, b.w}, gw4[4] = {g.x, g.y, g.z, g.w};
            float o[8]; float ss = 0.f;
#pragma unroll
            for (int q = 0; q < 4; ++q) { o[2 * q] = bf_lo(aw[q]) + bf_lo(bw[q]); o[2 * q + 1] = bf_hi(aw[q]) + bf_hi(bw[q]); ss += o[2 * q] * o[2 * q] + o[2 * q + 1] * o[2 * q + 1]; }
            ss = row16_sum(ss);
            const float rs = 1.f / sqrtf(ss * (1.f / 128.f) + 1e-6f);
            u32x4 y; unsigned yw[4];
#pragma unroll
            for (int q = 0; q < 4; ++q) yw[q] = pk2(o[2 * q] * rs * bf_lo(gw4[q]), o[2 * q + 1] * rs * bf_hi(gw4[q]));
            y.x = yw[0]; y.y = yw[1]; y.z = yw[2]; y.w = yw[3];
            *(u32x4*)(Y + (size_t)tok * PITCH + part * 512 + lane * 8) = y;
        }
#pragma unroll
        for (int part = 0; part < 2; ++part)
#pragma unroll
            for (int j = 0; j < 3; ++j) cur[part][j] = nxt[part][j];
        tok = tn;
    }
}

__device__ __forceinline__ float dpp_sum8(float v) {
    v += __builtin_bit_cast(float, __builtin_amdgcn_update_dpp(0, __builtin_bit_cast(int, v), 0xB1, 0xF, 0xF, true));
    v += __builtin_bit_cast(float, __builtin_amdgcn_update_dpp(0, __builtin_bit_cast(int, v), 0x4E, 0xF, 0xF, true));
    v += __builtin_bit_cast(float, __builtin_amdgcn_update_dpp(0, __builtin_bit_cast(int, v), 0x141, 0xF, 0xF, true));
    return v;
}
__device__ __forceinline__ int dpp_isum8(int v) {
    v += __builtin_amdgcn_update_dpp(0, v, 0xB1, 0xF, 0xF, true);
    v += __builtin_amdgcn_update_dpp(0, v, 0x4E, 0xF, 0xF, true);
    v += __builtin_amdgcn_update_dpp(0, v, 0x141, 0xF, 0xF, true);
    return v;
}
__device__ __forceinline__ void gather_down(const Args& A, int bid, int G, int wave, int lane) {
    const unsigned char* H2Q = A.ws + OFF_H2Q; const u16* IDX = (const u16*)(A.ws + OFF_IDX);
    const int x = bid & 7, nwx = (G >> 3) * NWAVES, wv = (bid >> 3) * NWAVES + wave;
    const unsigned char* DNS = (const unsigned char*)A.out + DOUT_DOWN + (size_t)x * 2097152 + (lane & 7) * 16;
    u16* PART = (u16*)(A.ws + OFF_PART) + (size_t)x * T_LAT * 128;
    const int r = lane >> 3;
    constexpr int U = 2;
    u32x4 ei[U][2], hq[U];
#pragma unroll
    for (int u = 0; u < U; ++u) { const int t0 = wv + u * nwx; const u32x4* ip0 = (const u32x4*)(IDX + (size_t)t0 * 128 + r * 16); ei[u][0] = ip0[0]; ei[u][1] = ip0[1];
        hq[u] = *(const u32x4*)(H2Q + (size_t)t0 * 1024 + x * 128 + (lane & 7) * 16); }
    for (int tok = wv; tok < T_LAT; tok += U * nwx) {
        u32x4 rows[U][16]; u32x4 hr[U];
#pragma unroll
        for (int u = 0; u < U; ++u) { const unsigned ew[8] = {ei[u][0].x, ei[u][0].y, ei[u][0].z, ei[u][0].w, ei[u][1].x, ei[u][1].y, ei[u][1].z, ei[u][1].w};
#pragma unroll
            for (int it = 0; it < 16; ++it) { const unsigned e = (it & 1) ? (ew[it >> 1] >> 16) : (ew[it >> 1] & 0xffffu); rows[u][it] = *(const u32x4*)(DNS + (size_t)e * 128); }
            hr[u] = hq[u]; }
#pragma unroll
        for (int u = 0; u < U; ++u) { const int tn = tok + (U + u) * nwx < T_LAT ? tok + (U + u) * nwx : tok; const u32x4* ipn = (const u32x4*)(IDX + (size_t)tn * 128 + r * 16); ei[u][0] = ipn[0]; ei[u][1] = ipn[1];
            hq[u] = *(const u32x4*)(H2Q + (size_t)tn * 1024 + x * 128 + (lane & 7) * 16); }
#pragma unroll
        for (int u = 0; u < U; ++u) { int res[16];
#pragma unroll
            for (int it = 0; it < 16; ++it) { int a = 0;
                a = __builtin_amdgcn_sdot4((int)rows[u][it].x, (int)hr[u].x, a, false); a = __builtin_amdgcn_sdot4((int)rows[u][it].y, (int)hr[u].y, a, false);
                a = __builtin_amdgcn_sdot4((int)rows[u][it].z, (int)hr[u].z, a, false); a = __builtin_amdgcn_sdot4((int)rows[u][it].w, (int)hr[u].w, a, false);
                res[it] = dpp_isum8(a); }
            if ((lane & 7) == 0) { u32x4* pp = (u32x4*)(PART + (size_t)(tok + u * nwx) * 128 + r * 16);
#pragma unroll
                for (int q = 0; q < 2; ++q) { u32x4 v; v.x = pkh2((float)res[8 * q] * 0.015625f, (float)res[8 * q + 1] * 0.015625f); v.y = pkh2((float)res[8 * q + 2] * 0.015625f, (float)res[8 * q + 3] * 0.015625f);
                    v.z = pkh2((float)res[8 * q + 4] * 0.015625f, (float)res[8 * q + 5] * 0.015625f); v.w = pkh2((float)res[8 * q + 6] * 0.015625f, (float)res[8 * q + 7] * 0.015625f); pp[q] = v; } } }
    }
}
__device__ __forceinline__ void gather_coef(const Args& A, int bid, int G, int tid) {
    const u16* PART = (const u16*)(A.ws + OFF_PART); const float* GWt = (const float*)(A.ws + OFF_GW); u16* COEF = (u16*)(A.ws + OFF_COEF);
    const u16* IDX = (const u16*)(A.ws + OFF_IDX); const float* HS = (const float*)(A.ws + OFF_HS); const float* DSC = (const float*)((const unsigned char*)A.out + DOUT_DSC);
    typedef int i32x4 __attribute__((ext_vector_type(4)));
    const int gt = bid * NTHREADS + tid, NGT = G * NTHREADS;
    for (int i = gt; i < T_LAT * 32; i += NGT) {
        f32x4 s = {0.f, 0.f, 0.f, 0.f}; u32x2 pv[8];
#pragma unroll
        for (int xs = 0; xs < 8; ++xs) pv[xs] = *(const u32x2*)(PART + (size_t)xs * T_LAT * 128 + (size_t)i * 4);
#pragma unroll
        for (int xs = 0; xs < 8; ++xs) { const f32x2 lo = unpkh2(pv[xs].x), hi = unpkh2(pv[xs].y); s.x += lo.x; s.y += lo.y; s.z += hi.x; s.w += hi.y; }
        s = s * 64.f;
        const f32x4 g = *(const f32x4*)(GWt + (size_t)i * 4); const u32x2 ew = *(const u32x2*)(IDX + (size_t)i * 4); const float hs = HS[i >> 5]; f32x4 o;
        { const float v = s.x * hs * DSC[ew.x & 0xffffu]; o.x = 0.5f * v * (1.f + erff(v * 0.70710678118654752f)) * g.x * (1.f / UP_SCALE); }
        { const float v = s.y * hs * DSC[ew.x >> 16];     o.y = 0.5f * v * (1.f + erff(v * 0.70710678118654752f)) * g.y * (1.f / UP_SCALE); }
        { const float v = s.z * hs * DSC[ew.y & 0xffffu]; o.z = 0.5f * v * (1.f + erff(v * 0.70710678118654752f)) * g.z * (1.f / UP_SCALE); }
        { const float v = s.w * hs * DSC[ew.y >> 16];     o.w = 0.5f * v * (1.f + erff(v * 0.70710678118654752f)) * g.w * (1.f / UP_SCALE); }
        u32x2 p; p.x = pk2(o.x, o.y); p.y = pk2(o.z, o.w); *(u32x2*)(COEF + (size_t)i * 4) = p;
    }
}
__device__ __forceinline__ float swapsum32(float x, float y) { const auto r = __builtin_amdgcn_permlane32_swap(__float_as_uint(x), __float_as_uint(y), false, false); return __uint_as_float(r[0]) + __uint_as_float(r[1]); }
__device__ __forceinline__ float swapsum16(float x, float y) { const auto r = __builtin_amdgcn_permlane16_swap(__float_as_uint(x), __float_as_uint(y), false, false); return __uint_as_float(r[0]) + __uint_as_float(r[1]); }
__device__ __forceinline__ float ror8add(float v) { return v + __uint_as_float(__builtin_amdgcn_update_dpp(0u, __float_as_uint(v), 0x128, 0xF, 0xF, true)); }
__device__ __forceinline__ float wave_sum_x(float v) {
    v += __uint_as_float(__builtin_amdgcn_update_dpp(0u, __float_as_uint(v), 0xB1, 0xF, 0xF, true));
    v += __uint_as_float(__builtin_amdgcn_update_dpp(0u, __float_as_uint(v), 0x4E, 0xF, 0xF, true));
    v += __uint_as_float(__builtin_amdgcn_update_dpp(0u, __float_as_uint(v), 0x141, 0xF, 0xF, true));
    v += __uint_as_float(__builtin_amdgcn_update_dpp(0u, __float_as_uint(v), 0x140, 0xF, 0xF, true));
    v = swapsum16(v, v); return swapsum32(v, v);
}
__device__ __forceinline__ void gather_up(const Args& A, int bid, int G, int wave, int lane) {
    const u16* IDX = (const u16*)(A.ws + OFF_IDX); const u16* COEF = (const u16*)(A.ws + OFF_COEF); float* SSQ = (float*)(A.ws + OFF_SSQ);
    const float* mod = (const float*)(A.ws + OFF_MOD); u16* out = (u16*)(A.ws + OFF_X1);
    const int x = bid & 7, nwx = (G >> 3) * NWAVES, wv = (bid >> 3) * NWAVES + wave;
    const unsigned char* UPS = (const unsigned char*)A.out + DOUT_UP + (size_t)x * 2097152 + (lane & 7) * 16;
    const int r = lane >> 3, col = x * 128 + (lane & 7) * 16 + 2 * r;
    const int nu = T_LAT / nwx;
    struct RS { u32x4 rows[16]; u32x4 cw[2]; unsigned x1v; };
    const f32x2 gvb0 = *(const f32x2*)(mod + 5 * 1024 + col), gvb1 = *(const f32x2*)(mod + 6144 + 5 * 1024 + col);
    RS SA, SB; u32x4 eiA[2], eiB[2];
    auto ld_idx = [&](int n, u32x4 (&ei)[2]) { const int t = wv + (n < nu ? n : nu - 1) * nwx; const u32x4* ip = (const u32x4*)(IDX + (size_t)t * 128 + r * 16); ei[0] = ip[0]; ei[1] = ip[1]; };
    auto ld_rows = [&](int n, const u32x4 (&ei)[2], RS& rs) { const int t = wv + (n < nu ? n : nu - 1) * nwx;
        const unsigned ew[8] = {ei[0].x, ei[0].y, ei[0].z, ei[0].w, ei[1].x, ei[1].y, ei[1].z, ei[1].w};
        const u32x4* cp = (const u32x4*)(COEF + (size_t)t * 128 + r * 16); rs.cw[0] = cp[0]; rs.cw[1] = cp[1];
        rs.x1v = *(const unsigned*)(out + (size_t)t * D + col);
#pragma unroll
        for (int it = 0; it < 16; ++it) { const unsigned e = (it & 1) ? (ew[it >> 1] >> 16) : (ew[it >> 1] & 0xffffu); rs.rows[it] = *(const u32x4*)(UPS + (size_t)e * 128); } };
    auto compute = [&](int n, const RS& rs) { const int t = wv + n * nwx;
        f32x2 acc[8];
#pragma unroll
        for (int q = 0; q < 8; ++q) { acc[q].x = 0.f; acc[q].y = 0.f; }
        const unsigned cww[8] = {rs.cw[0].x, rs.cw[0].y, rs.cw[0].z, rs.cw[0].w, rs.cw[1].x, rs.cw[1].y, rs.cw[1].z, rs.cw[1].w};
#pragma unroll
        for (int it = 0; it < 16; ++it) { const float ck = (it & 1) ? bf_hi(cww[it >> 1]) : bf_lo(cww[it >> 1]); f32x2 ck2; ck2.x = ck; ck2.y = ck; const unsigned w[4] = {rs.rows[it].x, rs.rows[it].y, rs.rows[it].z, rs.rows[it].w};
#pragma unroll
            for (int q = 0; q < 4; ++q) { const f32x2 lo = __builtin_amdgcn_cvt_pk_f32_fp8((int)w[q], false), hi = __builtin_amdgcn_cvt_pk_f32_fp8((int)w[q], true);
                acc[2 * q] = __builtin_elementwise_fma(ck2, lo, acc[2 * q]); acc[2 * q + 1] = __builtin_elementwise_fma(ck2, hi, acc[2 * q + 1]); } }
        f32x2 a4[4], a2[2], a1;
#pragma unroll
        for (int q = 0; q < 4; ++q) { a4[q].x = swapsum32(acc[q].x, acc[q + 4].x); a4[q].y = swapsum32(acc[q].y, acc[q + 4].y); }
#pragma unroll
        for (int q = 0; q < 2; ++q) { a2[q].x = swapsum16(a4[q].x, a4[q + 2].x); a2[q].y = swapsum16(a4[q].y, a4[q + 2].y); }
        { const bool hi = (lane & 8) != 0; f32x2 u0, u1; u0.x = ror8add(a2[0].x); u0.y = ror8add(a2[0].y); u1.x = ror8add(a2[1].x); u1.y = ror8add(a2[1].y); a1 = hi ? u1 : u0; }
        f32x2 x1f; x1f.x = bf_lo(rs.x1v); x1f.y = bf_hi(rs.x1v); const f32x2 x2f = x1f + ((t >> 13) ? gvb1 : gvb0) * a1; const unsigned pk = pk2(x2f.x, x2f.y); *(unsigned*)(out + (size_t)t * D + col) = pk;
        f32x2 x2; x2.x = bf_lo(pk); x2.y = bf_hi(pk);
        const float ss = wave_sum_x(x2.x * x2.x + x2.y * x2.y);
        if (lane == 0) SSQ[(size_t)t * 8 + x] = ss; };
    ld_idx(0, eiA); ld_idx(1, eiB);
    ld_rows(0, eiA, SA); ld_rows(1, eiB, SB);
    ld_idx(2, eiA); ld_idx(3, eiB);
    for (int n = 0; n < nu; n += 2) {
        compute(n, SA);
        ld_rows(n + 2, eiA, SA); ld_idx(n + 4, eiA);
        compute(n + 1, SB);
        ld_rows(n + 3, eiB, SB); ld_idx(n + 5, eiB);
    }
}
__device__ __forceinline__ void final_norm(const Args& A, int gw, int NGW, int lane) {
    const float* SSQ = (const float*)(A.ws + OFF_SSQ); const float* nfw = A.in[21]; const u16* x2 = (const u16*)(A.ws + OFF_X1); float* out = A.out;
    f32x4 wv[4], s0, s1; u32x2 x[4];
    { const f32x4* w4 = (const f32x4*)nfw + lane;
#pragma unroll
      for (int j = 0; j < 4; ++j) wv[j] = w4[64 * j]; }
    { const int tok = gw < T_LAT ? gw : T_LAT - 1; s0 = *(const f32x4*)(SSQ + (size_t)tok * 8); s1 = *(const f32x4*)(SSQ + (size_t)tok * 8 + 4); const u32x2* i4 = (const u32x2*)(x2 + (size_t)tok * D) + lane;
#pragma unroll
      for (int j = 0; j < 4; ++j) x[j] = i4[64 * j]; }
    for (int tok = gw; tok < T_LAT; tok += NGW) {
        const int tn = tok + NGW < T_LAT ? tok + NGW : tok; u32x2 xn[4];
        const f32x4 n0 = *(const f32x4*)(SSQ + (size_t)tn * 8), n1 = *(const f32x4*)(SSQ + (size_t)tn * 8 + 4); const u32x2* i4 = (const u32x2*)(x2 + (size_t)tn * D) + lane;
#pragma unroll
        for (int j = 0; j < 4; ++j) xn[j] = i4[64 * j];
        const float ss = ((s0.x + s0.y) + (s0.z + s0.w)) + ((s1.x + s1.y) + (s1.z + s1.w));
        const float rstd = 1.f / sqrtf(ss * (1.f / D) + 1e-6f);
        f32x4* o4 = (f32x4*)(out + (size_t)tok * D) + lane;
#pragma unroll
        for (int j = 0; j < 4; ++j) { f32x4 xf; xf.x = bf_lo(x[j].x); xf.y = bf_hi(x[j].x); xf.z = bf_lo(x[j].y); xf.w = bf_hi(x[j].y); o4[64 * j] = xf * rstd * wv[j]; }
#pragma unroll
        for (int j = 0; j < 4; ++j) x[j] = xn[j];
        s0 = n0; s1 = n1;
    }
}

__global__ void __launch_bounds__(NTHREADS) fwd_kernel(Args A) {
    extern __shared__ __attribute__((aligned(16))) unsigned char lds[];
    const int wave = __builtin_amdgcn_readfirstlane((int)threadIdx.x >> 6), bid = blockIdx.x, G = gridDim.x;
#define lane lane_id_asm()
#define tid (wave * 64 + lane)
    const int gw = bid * NWAVES + wave, NGW = G * NWAVES;
    const int lo = A.ph_lo, hi = A.ph_hi;
#if !N_LAUNCH_SPLIT
    volatile unsigned* bst = (volatile unsigned*)(lds + LDS_BYTES - 16);
    if (tid == 0) { bst[0] = 0u; bst[1] = 0u; }
    __syncthreads();
    XcdBarrier bar = xcd_barrier_post((unsigned*)(A.ws + OFF_CTL), bst);
#define GRID_BAR() xcd_barrier(bar)
#else
#define GRID_BAR() do {} while (0)
#endif
#define IN(k) (lo <= (k) && (k) < hi)
#define SEAM(k) do { if (IN(k) && IN((k) + 1)) GRID_BAR(); } while (0)
    const float* mod = (const float*)(A.ws + OFF_MOD);
#define OT(x) opaque_i(x)
    if (IN(0)) { phase0(A, lds, bid, G, OT(tid)); __syncthreads(); }
    if (IN(1)) norm_rows<false, false>(A.in[0], A.in[2], T_ALL, A.in[6], mod, 0, 1, (u16*)(A.ws + OFF_H), OT(gw), NGW, OT(lane), nullptr, nullptr, (unsigned*)(A.ws + OFF_CTL));
    SEAM(1);
    if (IN(2)) { EpiIn e{A.ws}; gemm_phase((const u16*)(A.ws + OFF_H), (const u16*)(A.ws + OFF_WIN), T_ALL / 256, NIN_PAD / 256, lds, e, bid, G, OT(tid));
        if (G == 256 && (bid >> 3) >= 28) { const int iw = ((bid >> 3) - 28) * 64 + (bid & 7) * 8 + wave, ln_ = OT(lane);
            for (int p = 0; p < 2; ++p) { HookDown hd{A.in[19], (unsigned char*)A.out + DOUT_DOWN, (float*)((unsigned char*)A.out + DOUT_DSC), 12288 + p * 2048 + iw, 256, ln_, 8};
                for (int t = 0; t < 4; ++t) { hd.issue(t, 4); hd.finish(t, 4); } hd.flush(); }
            for (int p = 0; p < 2; ++p) { HookUp hu{A.in[20], (unsigned char*)A.out + DOUT_UP, 786432 + p * 131072 + iw * 64 + ln_, 16384, 8};
                for (int t = 0; t < 4; ++t) { hu.issue(t, 4); hu.finish(t, 4); } } } }
    SEAM(2);
    if (IN(3)) {
        HookDown hd{A.in[19], (unsigned char*)A.out + DOUT_DOWN, (float*)((unsigned char*)A.out + DOUT_DSC), gw, NGW, OT(lane), G == 256 ? 6 : 8};
        HookUp hu{A.in[20], (unsigned char*)A.out + DOUT_UP, bid * NTHREADS + OT(tid), G * NTHREADS, G == 256 ? 6 : 8};
        scan_ret2<0>(A, lds, bid >> 4, bid & 15, OT(tid), hd); hd.flush(); __syncthreads(); scan_gla2<0>(A, lds, bid >> 4, bid & 15, OT(tid), hu); }
    SEAM(3);
    if (IN(4)) scan_combine(A, bid, G, OT(tid));
    SEAM(4);
    if (IN(5)) { HookNone hn; scan_ret2<1>(A, lds, bid >> 4, (bid & 15) + 1, OT(tid), hn); __syncthreads(); scan_gla2<1>(A, lds, bid >> 4, (bid & 15) + 1, OT(tid), hn); }
    SEAM(5);
    if (IN(6)) phase4(A, OT(gw), NGW, OT(lane));
    SEAM(6);
    if (IN(7)) { EpiOut e{A.in[0], mod, (u16*)(A.ws + OFF_X1)}; gemm_phase((const u16*)(A.ws + OFF_Y), (const u16*)(A.ws + OFF_WOUT), T_LAT / 256, 1024 / 256, lds, e, bid, G, OT(tid)); }
    SEAM(7);
    if (IN(8)) {
        norm_rows<true, true>((const float*)(A.ws + OFF_X1), nullptr, T_LAT, A.in[7], mod, 3, 4, (u16*)(A.ws + OFF_H2), OT(gw), NGW, OT(lane), A.ws + OFF_H2Q, (float*)(A.ws + OFF_HS));
    }
    SEAM(8);
    if (IN(9)) { EpiQTopk e{A.ws}; gemm_phase((const u16*)(A.ws + OFF_H2), (const u16*)(A.ws + OFF_WQ), T_LAT / 256, 2048 / 256, lds, e, bid, G, OT(tid)); }
    SEAM(9);
    if (IN(10)) gather_down(A, bid, G, wave, OT(lane));
    SEAM(10);
    if (IN(11)) gather_coef(A, bid, G, OT(tid));
    SEAM(11);
    if (IN(12)) gather_up(A, bid, G, wave, OT(lane));
    SEAM(12);
    if (IN(13)) final_norm(A, OT(gw), NGW, OT(lane));
#undef lane
#undef tid
}

extern "C" void kernel_launch(void* const* d_in, const int* in_sizes, int n_in, void* d_out, int out_size, void* d_ws, size_t ws_size, hipStream_t stream) {
    static int grid = 0;
    if (grid == 0) {
        if (n_in != 22 || out_size != T_LAT * D || ws_size < WS_NEED) { fprintf(stderr, "kernel_launch: unexpected shapes (n_in %d out %d ws %zu need %zu)\n", n_in, out_size, ws_size, (size_t)WS_NEED); grid = -1; return; }
        int dev = 0, cus = 0;
        if (hipGetDevice(&dev) != hipSuccess || hipDeviceGetAttribute(&cus, hipDeviceAttributeMultiprocessorCount, dev) != hipSuccess) { grid = -1; return; }
        if (hipFuncSetAttribute((const void*)fwd_kernel, hipFuncAttributeMaxDynamicSharedMemorySize, LDS_BYTES) != hipSuccess) { fprintf(stderr, "kernel_launch: hipFuncSetAttribute failed\n"); grid = -1; return; }
        int per_cu = 0;
        if (hipOccupancyMaxActiveBlocksPerMultiprocessor(&per_cu, (const void*)fwd_kernel, NTHREADS, LDS_BYTES) != hipSuccess || per_cu < 1) { fprintf(stderr, "kernel_launch: occupancy query says %d\n", per_cu); }
        (void)hipGetLastError();
        if (cus < 256) fprintf(stderr, "kernel_launch: %d CUs reported; this kernel is built for 256 (one 512-thread workgroup per CU)\n", cus);
        grid = 256;
    }
    if (grid < 0) return;
    (void)hipMemsetAsync((char*)d_ws + OFF_CTL, 0, CTL_BYTES, stream);
    Args a{};
    for (int i = 0; i < 22; ++i) a.in[i] = (const float*)d_in[i];
    a.out = (float*)d_out; a.ws = (unsigned char*)d_ws; a.rep = 0;
#if N_LAUNCH_SPLIT
    for (int p = 0; p < NPHASES; ++p) { a.ph_lo = p; a.ph_hi = p + 1; hipLaunchKernelGGL(fwd_kernel, dim3(grid), dim3(NTHREADS), LDS_BYTES, stream, a); }
#else
    a.ph_lo = 0; a.ph_hi = NPHASES;
    hipLaunchKernelGGL(fwd_kernel, dim3(grid), dim3(NTHREADS), LDS_BYTES, stream, a);
#endif
}
```
